# Optimizing an MI355X kernel written in HIP

```python
import jax, jax.numpy as jnp
from jax import lax
import numpy as np

D_MODEL = 1024
BATCH = 8
SEQ = 4096
DEPTH = 2

N_A = DEPTH // 2
N_B = DEPTH - N_A
M_HEADS = 4
M_QK = D_MODEL // (2 * M_HEADS)
M_V = D_MODEL // M_HEADS
M_CHUNK = 64
GATE_CAP = 15.0
M_IN = 2 * M_HEADS * M_QK + 2 * D_MODEL + 2 * M_HEADS
F_HEADS = 16
F_HD = D_MODEL // F_HEADS
Q_BLOCK = 128
KV_OUT = 2 * D_MODEL + F_HEADS
D_FF = ((-(-8 * D_MODEL // 3) + 255) // 256) * 256
EPS = 1e-6

kernel_name = "yoco_mlstm_fox_hybrid"


def rmsnorm(x, g):
    xf = x.astype(jnp.float32)
    y = xf * lax.rsqrt(jnp.mean(xf * xf, axis=-1, keepdims=True) + EPS)
    return (y * g.astype(jnp.float32)).astype(x.dtype)


def softcap(a, cap):
    return cap * jnp.tanh(a / cap)


def mlstm_chunkwise(q, k, v, ig, lf):
    B, H, S, dk = q.shape
    dv = v.shape[-1]
    L = M_CHUNK
    nc = S // L
    q = q * dk ** -0.5

    def to_chunks(a):
        return jnp.moveaxis(a.reshape(B, H, nc, L, *a.shape[3:]), 2, 0)

    qc, kc, vc, ic, fc = (to_chunks(a) for a in (q, k, v, ig, lf))
    causal = jnp.tril(jnp.ones((L, L), dtype=bool))

    def step(carry, inp):
        C, n, m = carry
        qb, kb, vb, ib, fb = inp
        b = jnp.cumsum(fb, axis=-1)
        dmat = jnp.where(causal, b[..., :, None] - b[..., None, :] + ib[..., None, :], -jnp.inf)
        inter = b + m[..., None]
        m_t = jnp.maximum(inter, jnp.max(dmat, axis=-1))
        w = jnp.exp(dmat - m_t[..., None])
        a = jnp.exp(inter - m_t)
        s = jnp.einsum('bhtd,bhsd->bhts', qb, kb) * w
        num = a[..., None] * jnp.einsum('bhtd,bhde->bhte', qb, C) + jnp.einsum('bhts,bhse->bhte', s, vb)
        den = a * jnp.einsum('bhtd,bhd->bht', qb, n) + jnp.sum(s, axis=-1)
        h = num / jnp.maximum(jnp.abs(den), jnp.exp(-m_t))[..., None]
        bl = b[..., -1]
        ws = bl[..., None] - b + ib
        m_new = jnp.maximum(bl + m, jnp.max(ws, axis=-1))
        a_c = jnp.exp(bl + m - m_new)
        ws = jnp.exp(ws - m_new[..., None])
        C = a_c[..., None, None] * C + jnp.einsum('bhs,bhsd,bhse->bhde', ws, kb, vb)
        n = a_c[..., None] * n + jnp.einsum('bhs,bhsd->bhd', ws, kb)
        return (C, n, m_new), h

    init = (jnp.zeros((B, H, dk, dv), jnp.float32), jnp.zeros((B, H, dk), jnp.float32),
            jnp.zeros((B, H), jnp.float32))
    _, h = lax.scan(step, init, (qc, kc, vc, ic, fc))
    return jnp.moveaxis(h, 0, 2).reshape(B, H, S, dv)


def mlstm_mixer(h, w_in, gate_b, hn_g, w_out):
    B, S, _ = h.shape
    dq = M_HEADS * M_QK
    proj = h @ w_in
    q, k, v, o, gi, gf = jnp.split(
        proj, [dq, 2 * dq, 2 * dq + D_MODEL, 2 * dq + 2 * D_MODEL, 2 * dq + 2 * D_MODEL + M_HEADS], axis=-1)
    heads = lambda a, d: a.reshape(B, S, M_HEADS, d).transpose(0, 2, 1, 3).astype(jnp.float32)
    q, k, v = heads(q, M_QK), heads(k, M_QK), heads(v, M_V)
    ig = softcap((gi + gate_b[:M_HEADS]).astype(jnp.float32), GATE_CAP).transpose(0, 2, 1)
    lf = jax.nn.log_sigmoid(softcap((gf + gate_b[M_HEADS:]).astype(jnp.float32), GATE_CAP)).transpose(0, 2, 1)
    hh = mlstm_chunkwise(q, k, v, ig, lf)
    hh = hh * lax.rsqrt(jnp.mean(hh * hh, axis=-1, keepdims=True) + EPS)
    hh = hh.transpose(0, 2, 1, 3).reshape(B, S, D_MODEL) * hn_g.astype(jnp.float32)
    y = jax.nn.sigmoid(o.astype(jnp.float32)) * hh
    return y.astype(h.dtype) @ w_out


def shared_kv(x, cs, g, mod_w, mod_b, w, f_b):
    B, S, _ = x.shape
    sh, sc = jnp.split((cs @ mod_w + mod_b)[:, None, :], 2, axis=-1)
    h = rmsnorm(x, g) * (1 + sc) + sh
    p = h @ w
    k, v, fg = jnp.split(p, [D_MODEL, 2 * D_MODEL], axis=-1)
    heads = lambda a: a.reshape(B, S, F_HEADS, F_HD).transpose(0, 2, 1, 3)
    logf = jax.nn.log_sigmoid((fg + f_b).astype(jnp.float32))
    F = jnp.cumsum(logf, axis=1).transpose(0, 2, 1)
    return heads(k), heads(v), F


def fox_attention(q, k, v, F):
    S = q.shape[2]
    scale = F_HD ** -0.5
    outs = []
    for i in range(S // Q_BLOCK):
        q0, q1 = i * Q_BLOCK, (i + 1) * Q_BLOCK
        qb, kb, vb = q[:, :, q0:q1], k[:, :, :q1], v[:, :, :q1]
        logits = (jnp.einsum('bhqd,bhkd->bhqk', qb, kb).astype(jnp.float32) * scale
                  + F[:, :, q0:q1, None] - F[:, :, None, :q1])
        mask = (q0 + jnp.arange(Q_BLOCK))[:, None] >= jnp.arange(q1)[None, :]
        p = jax.nn.softmax(jnp.where(mask, logits, -jnp.inf), axis=-1).astype(vb.dtype)
        outs.append(jnp.einsum('bhqk,bhkd->bhqd', p, vb))
    return jnp.concatenate(outs, axis=2)


def fox_mixer(h, k, v, F, w_q, w_out):
    B, S, _ = h.shape
    q = (h @ w_q).reshape(B, S, F_HEADS, F_HD).transpose(0, 2, 1, 3)
    o = fox_attention(q, k, v, F)
    return o.transpose(0, 2, 1, 3).reshape(B, S, D_MODEL) @ w_out


def swiglu(h, w_in, w_out):
    g, u = jnp.split(h @ w_in, 2, axis=-1)
    return (jax.nn.silu(g) * u) @ w_out


def setup_inputs(seed: int = 0) -> dict:
    key = jax.random.key(seed)
    ks = iter(jax.random.split(key, 32))
    D = D_MODEL
    nrm = lambda shape, s: jax.random.normal(next(ks), shape, jnp.float32) * s
    return {
        "x": nrm((BATCH, SEQ, D), 1.0),
        "c": nrm((BATCH, D), 1.0),
        "mod_w": nrm((DEPTH, D, 6 * D), D ** -0.5),
        "mod_b": nrm((DEPTH, 6 * D), 0.02),
        "mix_pre_g": 1.0 + nrm((DEPTH, D), 0.02),
        "mix_post_g": 1.0 + nrm((DEPTH, D), 0.02),
        "ffn_pre_g": 1.0 + nrm((DEPTH, D), 0.02),
        "ffn_post_g": 1.0 + nrm((DEPTH, D), 0.02),
        "ffn_w_in": nrm((DEPTH, D, 2 * D_FF), D ** -0.5),
        "ffn_w_out": nrm((DEPTH, D_FF, D), D_FF ** -0.5),
        "a_w_in": nrm((N_A, D, M_IN), D ** -0.5),
        "a_gate_b": nrm((N_A, 2 * M_HEADS), 0.02),
        "a_hnorm_g": 1.0 + nrm((N_A, D), 0.02),
        "a_w_out": nrm((N_A, D, D), D ** -0.5),
        "kv_norm_g": 1.0 + nrm((D,), 0.02),
        "kv_mod_w": nrm((D, 2 * D), D ** -0.5),
        "kv_mod_b": nrm((2 * D,), 0.02),
        "kv_w": nrm((D, KV_OUT), D ** -0.5),
        "kv_fgate_b": nrm((F_HEADS,), 0.02),
        "b_w_q": nrm((N_B, D, D), D ** -0.5),
        "b_w_out": nrm((N_B, D, D), D ** -0.5),
    }


def reference(x, c, mod_w, mod_b, mix_pre_g, mix_post_g, ffn_pre_g, ffn_post_g, ffn_w_in, ffn_w_out,
              a_w_in, a_gate_b, a_hnorm_g, a_w_out, kv_norm_g, kv_mod_w, kv_mod_b, kv_w, kv_fgate_b,
              b_w_q, b_w_out):
    cs = jax.nn.silu(c)
    k_sh = v_sh = F_sh = None
    for l in range(DEPTH):
        sh1, sc1, g1, sh2, sc2, g2 = jnp.split((cs @ mod_w[l] + mod_b[l])[:, None, :], 6, axis=-1)
        h = rmsnorm(x, mix_pre_g[l]) * (1 + sc1) + sh1
        if l < N_A:
            y = mlstm_mixer(h, a_w_in[l], a_gate_b[l], a_hnorm_g[l], a_w_out[l])
        else:
            if l == N_A:
                k_sh, v_sh, F_sh = shared_kv(x, cs, kv_norm_g, kv_mod_w, kv_mod_b, kv_w, kv_fgate_b)
            y = fox_mixer(h, k_sh, v_sh, F_sh, b_w_q[l - N_A], b_w_out[l - N_A])
        x = x + g1 * rmsnorm(y, mix_post_g[l])
        h = rmsnorm(x, ffn_pre_g[l]) * (1 + sc2) + sh2
        x = x + g2 * rmsnorm(swiglu(h, ffn_w_in[l], ffn_w_out[l]), ffn_post_g[l])
    return x
```

```cpp
#include <hip/hip_runtime.h>
#include <hip/hip_bf16.h>
#include <cstdio>
#include <cstdint>
#include <cmath>
namespace pg8 {
#define PG8_LAS __attribute__((address_space(3)))
typedef unsigned short bf16_t;
typedef short bf16x8 __attribute__((ext_vector_type(8)));
typedef float f32x4 __attribute__((ext_vector_type(4)));
typedef unsigned u32x4 __attribute__((ext_vector_type(4)));
constexpr int BM = 256, BK = 64, HALF = 128, HTB = HALF * BK * 2  , STAGE_BYTES = 8 * HTB, NXCD = 8, WGM = 8;

__host__ __device__ __forceinline__ int lds_byte(int r, int c) { const int st = (r >> 4) * 2 + (c >> 5), rr = r & 15, cc = c & 31, ob = rr * 64 + cc * 2; return st * 1024 + (ob ^ (((ob >> 9) & 1) << 5)); }
__host__ __device__ __forceinline__ void stage_rc(int b, int& R, int& C) { const int st = b / 1024, sb = b % 1024, swz = sb ^ (((sb >> 9) & 1) << 5); R = (st >> 1) * 16 + swz / 64; C = (st & 1) * 32 + (swz % 64) / 2; }
__host__ __device__ __forceinline__ int perm32(int rho) { const int n = rho >> 4, i = rho & 15; return 8 * (i >> 2) + 4 * n + (i & 3); }

struct Unit { int pm, pn; };
struct Gemm { const bf16_t* A; const bf16_t* Bt; int M, N, K; };

struct StaticOrder {
    int nM, nN, nwg, G, c;
    __host__ __device__ void init(int M, int N, int G_, int c_) { nM = M / BM; nN = N / BM; nwg = nM * nN; G = G_; c = c_; }
    __host__ __device__ bool next(int i, Unit& u) const {
        const long L = (long)i * G + c; if (L >= nwg) return false;
        int wgid = (int)L; { const int q = nwg / NXCD, r = nwg % NXCD, xcd = wgid % NXCD, off = wgid / NXCD; wgid = (xcd < r ? xcd * (q + 1) : r * (q + 1) + (xcd - r) * q) + off; }
        const int nig = WGM * nN, gid = wgid / nig, fm = gid * WGM, gsz = (nM - fm) < WGM ? (nM - fm) : WGM;
        u.pm = fm + ((wgid % nig) % gsz); u.pn = (wgid % nig) / gsz; return true;
    }
    __device__ __forceinline__ void a_ready(const Unit&) const {}
    __device__ __forceinline__ void done(const Unit&) const {}
};

__device__ __forceinline__ unsigned cvt_pk_bf16(float lo, float hi) { unsigned r; asm volatile("v_cvt_pk_bf16_f32 %0, %1, %2" : "=v"(r) : "v"(lo), "v"(hi)); return r; }
struct EpiBf16 {
    static constexpr bool PERM = true, AFTER_DRAIN = false;
    bf16_t* O; int ldc; int split_cols; size_t split_stride; float scale0;
    __device__ __forceinline__ void operator()(const f32x4 (&acc)[2][2][4][2], const Unit& u, int wr, int wc, int fr, int fq) const {
        const int row0 = u.pm * BM + wr * 64 + fr; int colt = u.pn * BM; bf16_t* base = O;
        float sc = 1.f; if (split_cols) { const int t = colt / split_cols; base += (size_t)t * split_stride; colt -= t * split_cols; if (t == 0) sc = scale0; }
        const int col0 = colt + wc * 32 + 8 * fq;
#pragma unroll
        for (int ai = 0; ai < 2; ++ai)
#pragma unroll
            for (int m = 0; m < 4; ++m) { bf16_t* rowp = base + (size_t)(row0 + ai * HALF + m * 16) * ldc + col0;
#pragma unroll
                for (int bj = 0; bj < 2; ++bj) { f32x4 v0 = acc[ai][bj][m][0], v1 = acc[ai][bj][m][1];
                    v0 = v0 * sc; v1 = v1 * sc; u32x4 w; w.x = cvt_pk_bf16(v0[0], v0[1]); w.y = cvt_pk_bf16(v0[2], v0[3]); w.z = cvt_pk_bf16(v1[0], v1[1]); w.w = cvt_pk_bf16(v1[2], v1[3]);
                    *(u32x4*)(rowp + bj * HALF) = w; } }
    }
};
__device__ __forceinline__ float silu_mul(float g, float u) { return g * u * __builtin_amdgcn_rcpf(1.0f + __builtin_amdgcn_exp2f(-1.4426950408889634f * g)); }
struct EpiSwiGLU {
    static constexpr bool PERM = true, AFTER_DRAIN = false;
    bf16_t* O; int ldc;
    __device__ __forceinline__ void operator()(const f32x4 (&acc)[2][2][4][2], const Unit& u, int wr, int wc, int fr, int fq) const {
        const int row0 = u.pm * BM + wr * 64 + fr; const int col0 = u.pn * HALF + wc * 32 + 8 * fq;
#pragma unroll
        for (int ai = 0; ai < 2; ++ai)
#pragma unroll
            for (int m = 0; m < 4; ++m) { bf16_t* rowp = O + (size_t)(row0 + ai * HALF + m * 16) * ldc + col0;
                const f32x4 g0 = acc[ai][0][m][0], g1 = acc[ai][0][m][1], u0 = acc[ai][1][m][0], u1 = acc[ai][1][m][1];
                u32x4 w; w.x = cvt_pk_bf16(silu_mul(g0[0], u0[0]), silu_mul(g0[1], u0[1])); w.y = cvt_pk_bf16(silu_mul(g0[2], u0[2]), silu_mul(g0[3], u0[3]));
                w.z = cvt_pk_bf16(silu_mul(g1[0], u1[0]), silu_mul(g1[1], u1[1])); w.w = cvt_pk_bf16(silu_mul(g1[2], u1[2]), silu_mul(g1[3], u1[3]));
                *(u32x4*)rowp = w; }
    }
};

template <class Epi, class Sched, bool ALIGN_EPI = false, bool SP2 = false>
__device__ __forceinline__ void gemm_phase(PG8_LAS unsigned char* lds, const Gemm g, const Sched& S, const Epi& E) {
    const int tid = threadIdx.x, wid = __builtin_amdgcn_readfirstlane(tid >> 6), lane = tid & 63, wr = wid >> 2, wc = wid & 3, fr = lane & 15, fq = lane >> 4;
    const int K = g.K, nt = K / BK;
    unsigned voffA[2], voffB[2];
#pragma unroll
    for (int i = 0; i < 2; ++i) { int R, C; stage_rc(tid * 16 + i * 8192, R, C); const int Rb = Epi::PERM ? ((R & ~31) + perm32(R & 31)) : R;
        voffA[i] = (unsigned)(R * K + C) * 2u; voffB[i] = (unsigned)(Rb * K + C) * 2u; }
    const size_t kstep = (size_t)(BK * 2);
    const size_t hstep = (size_t)HALF * K * 2;
    const size_t tstep = 2 * hstep;
    const unsigned ldsw = (unsigned)wid * 1024u;
    const int aoff = lds_byte(wr * 64 + fr, fq * 8), boff = lds_byte(wc * 32 + fr, fq * 8);
#define PG8_SA(b, h) (((b) * 2 + (h)) * HTB)
#define PG8_SB(b, h) ((4 + (b) * 2 + (h)) * HTB)
#define PG8_STAGE(bufoff, gbase, voff) do { _Pragma("unroll") for (int _i = 0; _i < 2; ++_i) \
        __builtin_amdgcn_global_load_lds((const unsigned*)((const char*)(gbase) + (voff)[_i]), (PG8_LAS unsigned*)(lds + (bufoff) + ldsw + _i * 8192), 16, 0, 0); } while (0)
#define PG8_LDA(dst, b, h) do { _Pragma("unroll") for (int m = 0; m < 4; ++m) _Pragma("unroll") for (int k = 0; k < 2; ++k) dst[m][k] = *(const PG8_LAS bf16x8*)(lds + PG8_SA(b, h) + aoff + m * 2048 + k * 1024); } while (0)
#define PG8_LDB(dst, b, h) do { _Pragma("unroll") for (int n = 0; n < 2; ++n) _Pragma("unroll") for (int k = 0; k < 2; ++k) dst[n][k] = *(const PG8_LAS bf16x8*)(lds + PG8_SB(b, h) + boff + n * 2048 + k * 1024); } while (0)
#define PG8_MMA(ai, bj, At, Bt) do { __builtin_amdgcn_s_setprio(1); _Pragma("unroll") for (int m = 0; m < 4; ++m) _Pragma("unroll") for (int n = 0; n < 2; ++n) _Pragma("unroll") for (int k = 0; k < 2; ++k) \
        acc[ai][bj][m][n] = __builtin_amdgcn_mfma_f32_16x16x32_bf16(Bt[n][k], At[m][k], acc[ai][bj][m][n], 0, 0, 0); __builtin_amdgcn_s_setprio(0); } while (0)
#define PG8_WAIT_V(n) asm volatile("s_waitcnt vmcnt(" #n ")" ::: "memory")
#define PG8_WAIT_L(n) asm volatile("s_waitcnt lgkmcnt(" #n ")" ::: "memory")
#define PG8_BAR __builtin_amdgcn_s_barrier()
#define PG8_SCHED __builtin_amdgcn_sched_barrier(0)
    Unit cur, nxt; int ui = 0;
    if (!S.next(0, cur)) return;
    f32x4 acc[2][2][4][2];
#pragma unroll
    for (int a = 0; a < 2; ++a)
#pragma unroll
        for (int b = 0; b < 2; ++b)
#pragma unroll
            for (int m = 0; m < 4; ++m)
#pragma unroll
                for (int n = 0; n < 2; ++n) acc[a][b][m][n] = (f32x4){0.f, 0.f, 0.f, 0.f};
    bf16x8 At[4][2], B0[2][2], B1[2][2];
    const char* cA = (const char*)g.A + (size_t)cur.pm * tstep; const char* cB = (const char*)g.Bt + (size_t)cur.pn * tstep;
    S.a_ready(cur);
    if constexpr (SP2) {
        PG8_STAGE(PG8_SB(0, 0), cB, voffB); PG8_STAGE(PG8_SB(0, 1), cB + hstep, voffB); PG8_STAGE(PG8_SA(0, 0), cA, voffA); PG8_STAGE(PG8_SA(0, 1), cA + hstep, voffA);
        if (wr == 1) PG8_BAR;
        PG8_WAIT_V(2); PG8_BAR;
        PG8_STAGE(PG8_SB(1, 0), cB + kstep, voffB); PG8_STAGE(PG8_SA(1, 0), cA + kstep, voffA); PG8_STAGE(PG8_SB(1, 1), cB + hstep + kstep, voffB);
        PG8_WAIT_V(6); PG8_BAR;
    } else {
        PG8_STAGE(PG8_SB(0, 0), cB, voffB); PG8_STAGE(PG8_SA(0, 0), cA, voffA); PG8_STAGE(PG8_SB(0, 1), cB + hstep, voffB); PG8_STAGE(PG8_SA(0, 1), cA + hstep, voffA);
        if (wr == 1) PG8_BAR;
        PG8_WAIT_V(4); PG8_BAR;
        PG8_STAGE(PG8_SB(1, 0), cB + kstep, voffB); PG8_STAGE(PG8_SA(1, 0), cA + kstep, voffA); PG8_STAGE(PG8_SB(1, 1), cB + hstep + kstep, voffB);
        PG8_WAIT_V(6); PG8_BAR;
    }
    for (;;) {
        const bool has_next = S.next(ui + 1, nxt);
        const char* nA = has_next ? (const char*)g.A + (size_t)nxt.pm * tstep : cA; const char* nB = has_next ? (const char*)g.Bt + (size_t)nxt.pn * tstep : cB;
        for (int t = 0; t < nt; t += 2) {
            const bool last = (t == nt - 2);
            const char* a1 = cA + (size_t)(t + 1) * kstep;
            const char* a2 = last ? nA : cA + (size_t)(t + 2) * kstep; const char* b2 = last ? nB : cB + (size_t)(t + 2) * kstep;
            const char* a3 = a2 + kstep; const char* b3 = b2 + kstep;
            if (last && has_next) S.a_ready(nxt);
            if constexpr (SP2) {
            PG8_LDB(B0, 0, 0); PG8_LDB(B1, 0, 1); PG8_SCHED; PG8_LDA(At, 0, 0); PG8_STAGE(PG8_SA(1, 1), a1 + hstep, voffA);
            PG8_WAIT_V(8); PG8_WAIT_L(0); PG8_BAR; PG8_MMA(0, 0, At, B0); PG8_MMA(0, 1, At, B1); PG8_BAR; PG8_SCHED;
            PG8_LDA(At, 0, 1); PG8_STAGE(PG8_SB(0, 0), b2, voffB); PG8_STAGE(PG8_SB(0, 1), b2 + hstep, voffB); PG8_STAGE(PG8_SA(0, 0), a2, voffA);
            PG8_WAIT_V(8); PG8_WAIT_L(0); PG8_BAR; PG8_MMA(1, 0, At, B0); PG8_MMA(1, 1, At, B1); PG8_BAR; PG8_SCHED;
            PG8_LDB(B0, 1, 0); PG8_LDB(B1, 1, 1); PG8_SCHED; PG8_LDA(At, 1, 0); PG8_STAGE(PG8_SA(0, 1), a2 + hstep, voffA);
            PG8_WAIT_V(8); PG8_WAIT_L(0); PG8_BAR; PG8_MMA(0, 0, At, B0); PG8_MMA(0, 1, At, B1); PG8_BAR; PG8_SCHED;
            PG8_LDA(At, 1, 1); PG8_STAGE(PG8_SB(1, 0), b3, voffB); PG8_STAGE(PG8_SB(1, 1), b3 + hstep, voffB); PG8_STAGE(PG8_SA(1, 0), a3, voffA);
            PG8_WAIT_V(8); PG8_WAIT_L(0); PG8_BAR; PG8_MMA(1, 0, At, B0); PG8_MMA(1, 1, At, B1); PG8_BAR; PG8_SCHED;
            } else {
            PG8_LDB(B0, 0, 0); PG8_SCHED; PG8_LDA(At, 0, 0); PG8_STAGE(PG8_SA(1, 1), a1 + hstep, voffA);
            PG8_WAIT_L(8); PG8_BAR; PG8_WAIT_L(0); PG8_MMA(0, 0, At, B0); PG8_BAR; PG8_SCHED;
            PG8_LDB(B1, 0, 1); PG8_STAGE(PG8_SB(0, 0), b2, voffB);
            PG8_BAR; PG8_WAIT_L(0); PG8_MMA(0, 1, At, B1); PG8_BAR;
            PG8_LDA(At, 0, 1); PG8_STAGE(PG8_SA(0, 0), a2, voffA);
            PG8_BAR; PG8_WAIT_L(0); PG8_MMA(1, 0, At, B0); PG8_BAR; PG8_SCHED;
            PG8_STAGE(PG8_SB(0, 1), b2 + hstep, voffB);
            PG8_WAIT_V(6); PG8_BAR; PG8_MMA(1, 1, At, B1); PG8_BAR;
            PG8_LDB(B0, 1, 0); PG8_SCHED; PG8_LDA(At, 1, 0); PG8_STAGE(PG8_SA(0, 1), a2 + hstep, voffA);
            PG8_WAIT_L(8); PG8_BAR; PG8_WAIT_L(0); PG8_MMA(0, 0, At, B0); PG8_BAR; PG8_SCHED;
            PG8_LDB(B1, 1, 1); PG8_STAGE(PG8_SB(1, 0), b3, voffB);
            PG8_BAR; PG8_WAIT_L(0); PG8_MMA(0, 1, At, B1); PG8_BAR;
            PG8_LDA(At, 1, 1); PG8_STAGE(PG8_SA(1, 0), a3, voffA);
            PG8_BAR; PG8_WAIT_L(0); PG8_MMA(1, 0, At, B0); PG8_BAR; PG8_SCHED;
            PG8_STAGE(PG8_SB(1, 1), b3 + hstep, voffB);
            PG8_WAIT_V(6); PG8_BAR; PG8_MMA(1, 1, At, B1); PG8_BAR;
            }
        }
        if constexpr (ALIGN_EPI) { if (wr == 0) PG8_BAR; }
        if constexpr (!Epi::AFTER_DRAIN) { E(acc, cur, wr, wc, fr, fq); S.done(cur); }
        if (!has_next) break;
#pragma unroll
        for (int a = 0; a < 2; ++a)
#pragma unroll
            for (int b = 0; b < 2; ++b)
#pragma unroll
                for (int m = 0; m < 4; ++m)
#pragma unroll
                    for (int n = 0; n < 2; ++n) acc[a][b][m][n] = (f32x4){0.f, 0.f, 0.f, 0.f};
        cur = nxt; cA = nA; cB = nB; ++ui;
        if constexpr (ALIGN_EPI) { if (wr == 1) PG8_BAR; }
    }
    PG8_WAIT_V(0);
    if constexpr (!ALIGN_EPI) { if (wr == 0) PG8_BAR; }
    PG8_BAR;
    if constexpr (Epi::AFTER_DRAIN) { E.fused(acc, cur, wr, wc, fr, fq, lds, wid, lane); S.done(cur); }
#undef PG8_SA
#undef PG8_SB
#undef PG8_STAGE
#undef PG8_LDA
#undef PG8_LDB
#undef PG8_MMA
#undef PG8_WAIT_V
#undef PG8_WAIT_L
#undef PG8_BAR
#undef PG8_SCHED
}
}
#define GAS __attribute__((address_space(1)))
#define LAS __attribute__((address_space(3)))
typedef unsigned short bf16;
typedef unsigned v4u __attribute__((ext_vector_type(4)));
typedef float f32x4 __attribute__((ext_vector_type(4)));
typedef short bf16x8 __attribute__((ext_vector_type(8)));
typedef GAS unsigned gu32;
typedef GAS unsigned long long gu64;
#define RLX_AGENT __ATOMIC_RELAXED, __HIP_MEMORY_SCOPE_AGENT
#define LDS_WAIT() asm volatile("s_waitcnt lgkmcnt(0)" ::: "memory")
#define VM_WAIT() asm volatile("s_waitcnt vmcnt(0)" ::: "memory")
__device__ __forceinline__ unsigned long long rt() { return __builtin_amdgcn_s_memrealtime(); }
__device__ __forceinline__ unsigned f2bf(float f) { unsigned u = __builtin_bit_cast(unsigned, f); return (u + 0x7fffu + ((u >> 16) & 1u)) >> 16; }
__device__ __forceinline__ unsigned pk2(float lo, float hi) { return f2bf(lo) | (f2bf(hi) << 16); }

#define XB_TMO      128
#define XB_XCNT(j)  (256  + 64 * (j))
#define XB_XSUB(j)  (1280 + 64 * (j))
#define XB_XGEN(j)  (2304 + 64 * (j))
#define XB_TOP      3328
#define XB_TOPGEN   3392
#define XCD_BAR_WORDS 3456
#define XB_SPIN_CAP (1u << 18)

__device__ __forceinline__ unsigned xb_ld(unsigned* p)              { return __hip_atomic_load(p, __ATOMIC_RELAXED, __HIP_MEMORY_SCOPE_AGENT); }
__device__ __forceinline__ unsigned xb_add(unsigned* p, unsigned v) { return __hip_atomic_fetch_add(p, v, __ATOMIC_RELAXED, __HIP_MEMORY_SCOPE_AGENT); }
__device__ __forceinline__ unsigned xb_xcc_id() { return (unsigned)__builtin_amdgcn_s_getreg((3 << 11) | 20) & 0xFu; }
#define XB_SPIN(cond, bar) do { unsigned _sp = 0; while (cond) { __builtin_amdgcn_s_sleep(1); \
    if ((++_sp & 255u) == 0u) { if (xb_ld(&(bar)[XB_TMO])) break; if (_sp > XB_SPIN_CAP) { atomicAdd(&(bar)[XB_TMO], 1u); break; } } } } while (0)

struct XcdBarrier {
    unsigned* bar; unsigned x;
    volatile LAS unsigned* st;
};

__device__ __forceinline__ XcdBarrier xcd_barrier_post(unsigned* bar, volatile LAS unsigned* st) {
    XcdBarrier b; b.bar = bar; b.x = xb_xcc_id(); b.st = st;
    if (threadIdx.x == 0) (void)xb_add(&bar[XB_XCNT(b.x)], 1u);
    return b;
}
__device__ __forceinline__ void xcd_barrier_complete(unsigned* bar, unsigned x, unsigned& nloc, unsigned& nx) {
    const unsigned G = gridDim.x * gridDim.y * gridDim.z;
    unsigned sum, cnt, mine, sp = 0u;
    for (;;) {
        sum = 0u; cnt = 0u; mine = 0u;
#pragma unroll
        for (unsigned j = 0; j < 16; ++j) { const unsigned c = xb_ld(&bar[XB_XCNT(j)]); sum += c; cnt += (c > 0u) ? 1u : 0u; mine = (j == x) ? c : mine; }
        if (sum == G) break;
        __builtin_amdgcn_s_sleep(1);
        if ((++sp & 255u) == 0u) { if (xb_ld(&bar[XB_TMO])) break; if (sp > XB_SPIN_CAP) { atomicAdd(&bar[XB_TMO], 1u); break; } }
    }
    nloc = mine > 0u ? mine : 1u; nx = cnt > 0u ? cnt : 1u;
}

__device__ __forceinline__ void xcd_barrier(const XcdBarrier& b) {
    asm volatile("s_waitcnt vmcnt(0)" ::: "memory");
    __syncthreads();
    if (threadIdx.x == 0) {
        unsigned* bar = b.bar;
        __builtin_amdgcn_s_waitcnt(0);
        unsigned nloc = b.st[0], nx = b.st[1];
        if (nloc == 0u) { xcd_barrier_complete(bar, b.x, nloc, nx); b.st[0] = nloc; b.st[1] = nx; }
        const unsigned old = xb_add(&bar[XB_XSUB(b.x)], 1u);
        const unsigned gen = old / nloc;
        if (old + 1u == (gen + 1u) * nloc) {
            __builtin_amdgcn_fence(__ATOMIC_RELEASE, "agent");
            asm volatile("s_waitcnt vmcnt(0)" ::: "memory");
            const unsigned og = xb_add(&bar[XB_TOP], 1u);
            const unsigned tg = og / nx;
            if (og + 1u == (tg + 1u) * nx) xb_add(&bar[XB_TOPGEN], 1u);
            else XB_SPIN(xb_ld(&bar[XB_TOPGEN]) == tg, bar);
            __builtin_amdgcn_fence(__ATOMIC_ACQUIRE, "agent");
            xb_add(&bar[XB_XGEN(b.x)], 1u);
            asm volatile("s_waitcnt vmcnt(0)" ::: "memory");
        } else {
            XB_SPIN(xb_ld(&bar[XB_XGEN(b.x)]) == gen, bar);
            __builtin_amdgcn_fence(__ATOMIC_ACQUIRE, "agent");
            asm volatile("s_waitcnt vmcnt(0)" ::: "memory");
        }
    }
    __syncthreads();
}
constexpr int NWAVES = 8;
constexpr int BATCH = 8, SEQ = 4096, D = 1024, M = BATCH * SEQ;
constexpr int MH = 4, MQK = 128, MV = 256, M_IN = 3080, M_INP = 3072;
constexpr int FH = 16, FHD = 64, KV_OUT = 2064;
constexpr int DFF = 2816;
constexpr float EPS = 1e-6f, GATE_CAP = 15.0f;
constexpr float LOG2E = 1.4426950408889634f;
constexpr float QSCALE2 = 0.125f * LOG2E;

constexpr size_t MiB = 1u << 20;
constexpr size_t WS_CTL = 0, CTL_ZERO_BYTES = 1 * MiB;
constexpr size_t WS_MOD = 1 * MiB;
constexpr size_t WS_IG = 2 * MiB, WS_LF = 2 * MiB + 512 * 1024;
constexpr size_t WS_LOGF = 3 * MiB, WS_F2 = 5 * MiB;
constexpr size_t WS_WA_IN = 8 * MiB, WS_WA_OUT = 14 * MiB, WS_WKV = 16 * MiB, WS_WQ = 20 * MiB, WS_WBO = 22 * MiB;
constexpr size_t WS_WFI = 24 * MiB, WFI_STRIDE = 11 * MiB;
constexpr size_t WS_WFO = 46 * MiB, WFO_STRIDE = 5632 * 1024;
constexpr size_t WS_RA = 64 * MiB, WS_RB = 128 * MiB, WS_RD = 192 * MiB, WS_RP = 256 * MiB, WS_END = 448 * MiB;
constexpr int CW_BAR = 4096;

constexpr int RING_OFF = 0, RING_BYTES = 131072;
constexpr int LDSCTL_OFF = RING_BYTES, MISC_OFF = LDSCTL_OFF + 320;
constexpr int LDS_BYTES = 147456;

typedef GAS f32x4 gf32x4;
typedef unsigned u32x2 __attribute__((ext_vector_type(2)));
__device__ __forceinline__ float bf2f(unsigned short h) { return __builtin_bit_cast(float, (unsigned)h << 16); }
__device__ __forceinline__ float bflo(unsigned w) { return __builtin_bit_cast(float, w << 16); }
__device__ __forceinline__ float bfhi(unsigned w) { return __builtin_bit_cast(float, w & 0xffff0000u); }

struct Frame {
    LAS unsigned char* lds;
    volatile LAS unsigned* MISC;
    gu32* ctl;
    int tid, lane, wave, G;
    const float* const* in; float* out; unsigned char* ws;
};
enum { I_X = 0, I_C, I_MOD_W, I_MOD_B, I_MIX_PRE_G, I_MIX_POST_G, I_FFN_PRE_G, I_FFN_POST_G, I_FFN_W_IN, I_FFN_W_OUT, I_A_W_IN, I_A_GATE_B, I_A_HNORM_G, I_A_W_OUT,
       I_KV_NORM_G, I_KV_MOD_W, I_KV_MOD_B, I_KV_W, I_KV_FGATE_B, I_B_W_Q, I_B_W_OUT };

__device__ __forceinline__ float wave_sum(float v) {
#pragma unroll
    for (int o = 1; o < 64; o <<= 1) v += __shfl_xor(v, o);
    return v;
}
__device__ __forceinline__ float dot4(f32x4 a, f32x4 b) { return (a.x * b.x + a.y * b.y) + (a.z * b.z + a.w * b.w); }
__device__ __forceinline__ float softcapf(float a) { return GATE_CAP * tanhf(a * (1.0f / GATE_CAP)); }
__device__ __forceinline__ float logsigf(float x) { return fminf(x, 0.f) - log1pf(expf(-fabsf(x))); }

__device__ __forceinline__ void ld_row_f32(const float* p, int lane, f32x4 (&v)[4]) {
    const gf32x4* xr = (const gf32x4*)p + lane;
#pragma unroll
    for (int j = 0; j < 4; ++j) v[j] = xr[64 * j];
}
__device__ __forceinline__ void st_row_f32(float* p, int lane, const f32x4 (&v)[4]) {
    gf32x4* xr = (gf32x4*)p + lane;
#pragma unroll
    for (int j = 0; j < 4; ++j) xr[64 * j] = v[j];
}
__device__ __forceinline__ void ld_row_bf16(const bf16* p, int lane, f32x4 (&v)[4]) {
    const GAS u32x2* xr = (const GAS u32x2*)p + lane;
#pragma unroll
    for (int j = 0; j < 4; ++j) { const u32x2 w = xr[64 * j]; v[j] = (f32x4){bflo(w.x), bfhi(w.x), bflo(w.y), bfhi(w.y)}; }
}
__device__ __forceinline__ void st_row_bf16(bf16* p, int lane, const f32x4 (&v)[4]) {
    GAS u32x2* xr = (GAS u32x2*)p + lane;
#pragma unroll
    for (int j = 0; j < 4; ++j) { u32x2 w; w.x = pk2(v[j].x, v[j].y); w.y = pk2(v[j].z, v[j].w); xr[64 * j] = w; }
}
__device__ __forceinline__ float row_sumsq(const f32x4 (&v)[4]) {
    float s = 0.f;
#pragma unroll
    for (int j = 0; j < 4; ++j) s += dot4(v[j], v[j]);
    return wave_sum(s);
}

__device__ __forceinline__ void p0_transpose_item(const float* W, int K, int ldn, int c0, int k0, bf16* WT, int r0, LAS float* scr, int lane) {
#pragma unroll 8
    for (int i = 0; i < 32; ++i) { const int kk = 2 * i + (lane >> 5); scr[kk * 33 + (lane & 31)] = W[(size_t)(k0 + kk) * ldn + c0 + (lane & 31)]; }
    LDS_WAIT(); asm volatile("" ::: "memory");
    const int c = lane & 7;
#pragma unroll
    for (int j = 0; j < 4; ++j) { const int n = (lane >> 3) + 8 * j; const LAS float* s = scr + (8 * c) * 33 + n;
        v4u o; o.x = pk2(s[0 * 33], s[1 * 33]); o.y = pk2(s[2 * 33], s[3 * 33]); o.z = pk2(s[4 * 33], s[5 * 33]); o.w = pk2(s[6 * 33], s[7 * 33]);
        *(GAS v4u*)(WT + (size_t)(r0 + n) * K + k0 + 8 * c) = o; }
    LDS_WAIT(); asm volatile("" ::: "memory");
}
__device__ __forceinline__ bool p0_matrix(int& r, const float* W, int K, int ldn, int ncols, bf16* WT, int swiglu, LAS float* scr, int lane) {
    const int ncb = ncols / 32, nit = (K / 64) * ncb;
    if (r >= nit) { r -= nit; return false; }
    const int kb = r / ncb, cb = r % ncb, c0 = 32 * cb;
    int r0 = c0;
    if (swiglu) { const int isu = c0 >= DFF ? 1 : 0, j = c0 - isu * DFF; r0 = (j >> 7) * 256 + isu * 128 + (j & 127); }
    p0_transpose_item(W, K, ldn, c0, 64 * kb, WT, r0, scr, lane);
    return true;
}
__device__ __forceinline__ void p0_prologue(Frame& F) {
    const int gw = blockIdx.x * NWAVES + F.wave, NGW = F.G * NWAVES;
    {
        LAS float* csL = (LAS float*)(F.lds);
        LAS float* part = (LAS float*)(F.lds + 32768);
        for (int u = F.tid; u < 8 * 1024; u += NWAVES * 64) { const float c = F.in[I_C][u]; csL[u] = c / (1.0f + expf(-c)); }
        LDS_WAIT(); __syncthreads();
        float* MOD = (float*)(F.ws + WS_MOD);
        for (int it = blockIdx.x; it < 224; it += F.G) {
            const float* W; const float* bias; float* out; int N, n0;
            if (it < 192) { const int l = it / 96; N = 6144; n0 = 64 * (it % 96); W = F.in[I_MOD_W] + (size_t)l * 1024 * 6144; bias = F.in[I_MOD_B] + l * 6144; out = MOD + (size_t)l * 8 * 6144; }
            else { N = 2048; n0 = 64 * (it - 192); W = F.in[I_KV_MOD_W]; bias = F.in[I_KV_MOD_B]; out = MOD + (size_t)2 * 8 * 6144; }
            float acc[8];
#pragma unroll
            for (int b = 0; b < 8; ++b) acc[b] = 0.f;
            const int kbeg = 128 * F.wave;
#pragma unroll 8
            for (int k = 0; k < 128; ++k) { const float w = W[(size_t)(kbeg + k) * N + n0 + F.lane];
#pragma unroll
                for (int b = 0; b < 8; ++b) acc[b] += csL[b * 1024 + kbeg + k] * w; }
#pragma unroll
            for (int b = 0; b < 8; ++b) part[(F.wave * 8 + b) * 64 + F.lane] = acc[b];
            LDS_WAIT(); __syncthreads();
            { const int b = F.wave; float s = bias[n0 + F.lane];
#pragma unroll
              for (int w = 0; w < 8; ++w) s += part[(w * 8 + b) * 64 + F.lane];
              out[(size_t)b * N + n0 + F.lane] = s; }
            LDS_WAIT(); __syncthreads();
        }
        __syncthreads();
    }
    LAS float* scr = (LAS float*)(F.lds + RING_OFF + F.wave * 16384);
    constexpr int NITEMS = 16 * 96 + 16 * 32 + 16 * 64 + 16 * 32 + 16 * 32 + 2 * (16 * 176) + 2 * (44 * 32);
    for (int it = gw; it < NITEMS; it += NGW) {
        int r = it;
        if (p0_matrix(r, F.in[I_A_W_IN], 1024, M_IN, M_INP, (bf16*)(F.ws + WS_WA_IN), 0, scr, F.lane)) continue;
        if (p0_matrix(r, F.in[I_A_W_OUT], 1024, 1024, 1024, (bf16*)(F.ws + WS_WA_OUT), 0, scr, F.lane)) continue;
        if (p0_matrix(r, F.in[I_KV_W], 1024, KV_OUT, 2048, (bf16*)(F.ws + WS_WKV), 0, scr, F.lane)) continue;
        if (p0_matrix(r, F.in[I_B_W_Q], 1024, 1024, 1024, (bf16*)(F.ws + WS_WQ), 0, scr, F.lane)) continue;
        if (p0_matrix(r, F.in[I_B_W_OUT], 1024, 1024, 1024, (bf16*)(F.ws + WS_WBO), 0, scr, F.lane)) continue;
        if (p0_matrix(r, F.in[I_FFN_W_IN], 1024, 2 * DFF, 2 * DFF, (bf16*)(F.ws + WS_WFI), 1, scr, F.lane)) continue;
        if (p0_matrix(r, F.in[I_FFN_W_IN] + (size_t)1024 * 2 * DFF, 1024, 2 * DFF, 2 * DFF, (bf16*)(F.ws + WS_WFI + WFI_STRIDE), 1, scr, F.lane)) continue;
        if (p0_matrix(r, F.in[I_FFN_W_OUT], DFF, 1024, 1024, (bf16*)(F.ws + WS_WFO), 0, scr, F.lane)) continue;
        p0_matrix(r, F.in[I_FFN_W_OUT] + (size_t)DFF * 1024, DFF, 1024, 1024, (bf16*)(F.ws + WS_WFO + WFO_STRIDE), 0, scr, F.lane);
    }
}

constexpr int ROWS_PER_WAVE = 16;
static_assert(M == 256 * NWAVES * ROWS_PER_WAVE, "row phases assume a 256-workgroup grid");

__device__ __forceinline__ void ld_par(const float* p, int lane, f32x4 (&v)[4]) { ld_row_f32(p, lane, v); }

__device__ __forceinline__ void stage_gate_w(Frame& F, const float* W, int ldn, int c0, int ncol) {
    LAS float* T = (LAS float*)F.lds;
    for (int u = F.tid; u < ncol * 1024; u += NWAVES * 64) { const int k = u / ncol, c = u % ncol; T[c * 1024 + k] = W[(size_t)k * ldn + c0 + c]; }
    LDS_WAIT(); __syncthreads();
}
__device__ __forceinline__ float gate_dot(Frame& F, const f32x4 (&h)[4], int c) {
    const LAS f32x4* T = (const LAS f32x4*)(F.lds) + c * 256 + F.lane;
    float s = 0.f;
#pragma unroll
    for (int j = 0; j < 4; ++j) s += dot4(h[j], T[64 * j]);
    return s;
}

__device__ __forceinline__ void row_phase_A(Frame& F) {
    stage_gate_w(F, F.in[I_A_W_IN], M_IN, M_INP, 8);
    const int gw = blockIdx.x * NWAVES + F.wave, m0 = gw * ROWS_PER_WAVE, b = m0 / SEQ, lane = F.lane;
    const float* mod = (const float*)(F.ws + WS_MOD) + (size_t)b * 6144;
    f32x4 gs[4], sh[4];
    { f32x4 g[4], sc[4]; ld_par(F.in[I_MIX_PRE_G], lane, g); ld_par(mod + 1024, lane, sc); ld_par(mod, lane, sh);
#pragma unroll
      for (int j = 0; j < 4; ++j) gs[j] = g[j] * (sc[j] + 1.0f); }
    bf16* XN = (bf16*)(F.ws + WS_RA);
    float* IG = (float*)(F.ws + WS_IG); float* LFp = (float*)(F.ws + WS_LF);
    const float gb = F.in[I_A_GATE_B][lane & 7];
    for (int i = 0; i < ROWS_PER_WAVE; ++i) {
        const int m = m0 + i, s = m - b * SEQ;
        f32x4 v[4]; ld_row_f32(F.in[I_X] + (size_t)m * D, lane, v);
        const float r = 1.0f / sqrtf(row_sumsq(v) * (1.0f / D) + EPS);
#pragma unroll
        for (int j = 0; j < 4; ++j) v[j] = v[j] * r * gs[j] + sh[j];
        st_row_bf16(XN + (size_t)m * D, lane, v);
        float mine = 0.f;
#pragma unroll 1
        for (int c = 0; c < 8; ++c) { const float t = wave_sum(gate_dot(F, v, c)); if (lane == c) mine = t; }
        if (lane < 8) { const float a = softcapf(mine + gb);
            if (lane < 4) IG[(size_t)(b * MH + lane) * SEQ + s] = a; else LFp[(size_t)(b * MH + lane - 4) * SEQ + s] = logsigf(a); }
    }
    __syncthreads();
}
__device__ __forceinline__ void row_phase_B(Frame& F) {
    const int gw = blockIdx.x * NWAVES + F.wave, m0 = gw * ROWS_PER_WAVE, lane = F.lane;
    f32x4 hg[4]; ld_par(F.in[I_A_HNORM_G], lane, hg);
    const bf16* HH = (const bf16*)(F.ws + WS_RB); const bf16* PROJ = (const bf16*)(F.ws + WS_RP); bf16* Y = (bf16*)(F.ws + WS_RA);
    for (int i = 0; i < ROWS_PER_WAVE; ++i) {
        const int m = m0 + i;
        f32x4 v[4], o[4]; ld_row_bf16(HH + (size_t)m * D, lane, v); ld_row_bf16(PROJ + (size_t)m * M_INP + 2048, lane, o);
#pragma unroll
        for (int j = 0; j < 4; ++j) { const float r = 1.0f / sqrtf(wave_sum(dot4(v[j], v[j])) * (1.0f / MV) + EPS);
            f32x4 sg; sg.x = 1.0f / (1.0f + expf(-o[j].x)); sg.y = 1.0f / (1.0f + expf(-o[j].y)); sg.z = 1.0f / (1.0f + expf(-o[j].z)); sg.w = 1.0f / (1.0f + expf(-o[j].w));
            v[j] = sg * (v[j] * r * hg[j]); }
        st_row_bf16(Y + (size_t)m * D, lane, v);
    }
}
template <int MODE>
__device__ __forceinline__ void row_phase_C(Frame& F, const float* x_old, const float* post_g, const float* gate_base  ,
                                            const float* pre_g, const float* scsh_base  ) {
    if (MODE == 1) stage_gate_w(F, F.in[I_KV_W], KV_OUT, 2048, 16);
    const int gw = blockIdx.x * NWAVES + F.wave, m0 = gw * ROWS_PER_WAVE, b = m0 / SEQ, lane = F.lane;
    f32x4 gp[4];
    { f32x4 pg[4], gt[4]; ld_par(post_g, lane, pg); ld_par(gate_base + (size_t)b * 6144, lane, gt);
#pragma unroll
      for (int j = 0; j < 4; ++j) gp[j] = pg[j] * gt[j]; }
    f32x4 gs[4], sh[4], gs2[4], sh2[4];
    if (MODE != 2) { f32x4 g[4], sc[4]; ld_par(pre_g, lane, g); ld_par(scsh_base + (size_t)b * 6144 + 1024, lane, sc); ld_par(scsh_base + (size_t)b * 6144, lane, sh);
#pragma unroll
      for (int j = 0; j < 4; ++j) gs[j] = g[j] * (sc[j] + 1.0f); }
    if (MODE == 1) { const float* kvm = (const float*)(F.ws + WS_MOD) + (size_t)2 * 8 * 6144 + (size_t)b * 2048;
      f32x4 g[4], sc[4]; ld_par(F.in[I_KV_NORM_G], lane, g); ld_par(kvm + 1024, lane, sc); ld_par(kvm, lane, sh2);
#pragma unroll
      for (int j = 0; j < 4; ++j) gs2[j] = g[j] * (sc[j] + 1.0f); }
    const bf16* Z = (const bf16*)(F.ws + WS_RD); bf16* XN = (bf16*)(F.ws + WS_RA); bf16* XN2 = (bf16*)(F.ws + WS_RB);
    float* LOGF = (float*)(F.ws + WS_LOGF);
    const float fb = (MODE == 1) ? F.in[I_KV_FGATE_B][lane & 15] : 0.f;
    for (int i = 0; i < ROWS_PER_WAVE; ++i) {
        const int m = m0 + i, s = m - b * SEQ;
        f32x4 z[4], x[4]; ld_row_bf16(Z + (size_t)m * D, lane, z); ld_row_f32(x_old + (size_t)m * D, lane, x);
        const float rz = 1.0f / sqrtf(row_sumsq(z) * (1.0f / D) + EPS);
#pragma unroll
        for (int j = 0; j < 4; ++j) x[j] = x[j] + gp[j] * (z[j] * rz);
        st_row_f32(F.out + (size_t)m * D, lane, x);
        if (MODE != 2) {
            const float r = 1.0f / sqrtf(row_sumsq(x) * (1.0f / D) + EPS);
            f32x4 h[4];
#pragma unroll
            for (int j = 0; j < 4; ++j) h[j] = x[j] * r * gs[j] + sh[j];
            st_row_bf16(XN + (size_t)m * D, lane, h);
            if (MODE == 1) {
#pragma unroll
                for (int j = 0; j < 4; ++j) h[j] = x[j] * r * gs2[j] + sh2[j];
                st_row_bf16(XN2 + (size_t)m * D, lane, h);
                float mine = 0.f;
#pragma unroll 1
                for (int c = 0; c < 16; ++c) { const float t = wave_sum(gate_dot(F, h, c)); if (lane == c) mine = t; }
                if (lane < 16) LOGF[(size_t)(b * FH + lane) * SEQ + s] = logsigf(mine + fb);
            }
        }
    }
    if (MODE == 1) __syncthreads();
}
__device__ __forceinline__ void cumsum_f2(Frame& F) {
    const int gw = blockIdx.x * NWAVES + F.wave;
    if (gw >= BATCH * FH) return;
    const float* src = (const float*)(F.ws + WS_LOGF) + (size_t)gw * SEQ + 64 * F.lane; float* dst = (float*)(F.ws + WS_F2) + (size_t)gw * SEQ + 64 * F.lane;
    float tot = 0.f;
    for (int i = 0; i < 16; ++i) { const f32x4 v = *(const gf32x4*)(src + 4 * i); tot += (v.x + v.y) + (v.z + v.w); }
    float incl = tot;
#pragma unroll
    for (int o = 1; o < 64; o <<= 1) { const float t = __shfl_up(incl, o); if (F.lane >= o) incl += t; }
    float run = incl - tot;
    for (int i = 0; i < 16; ++i) { const f32x4 v = *(const gf32x4*)(src + 4 * i); f32x4 o;
        run += v.x; o.x = run * LOG2E; run += v.y; o.y = run * LOG2E; run += v.z; o.z = run * LOG2E; run += v.w; o.w = run * LOG2E;
        *(gf32x4*)(dst + 4 * i) = o; }
}

__device__ __forceinline__ void mlstm_naive(Frame& F) {
    LAS float* qs = (LAS float*)(F.lds);
    LAS float* ks = qs + 32 * 128;
    LAS float* vs = ks + 32 * 128;
    LAS float* nums = vs + 32 * 256;
    LAS float* gts = nums + 32 * 257;
    LAS float* ems = gts + 96;
    const bf16* PROJ = (const bf16*)(F.ws + WS_RP); bf16* HH = (bf16*)(F.ws + WS_RB);
    const float* IG = (const float*)(F.ws + WS_IG); const float* LFp = (const float*)(F.ws + WS_LF);
    const float qscale = 0.08838834764831845f;
    for (int bh = blockIdx.x; bh < BATCH * MH; bh += F.G) {
        const int b = bh / MH, h = bh % MH;
        float C[128];
#pragma unroll
        for (int k = 0; k < 128; ++k) C[k] = 0.f;
        float mrun = 0.f;
        for (int s0 = 0; s0 < SEQ; s0 += 32) {
            __syncthreads();
            for (int u = F.tid; u < 32 * 128; u += NWAVES * 64) { const int t = u >> 7, k = u & 127; const bf16* row = PROJ + (size_t)(b * SEQ + s0 + t) * M_INP;
                qs[u] = bf2f(row[h * MQK + k]) * qscale; ks[u] = bf2f(row[512 + h * MQK + k]); }
            for (int u = F.tid; u < 32 * 256; u += NWAVES * 64) { const int t = u >> 8, c = u & 255; vs[u] = bf2f(PROJ[(size_t)(b * SEQ + s0 + t) * M_INP + 1024 + h * MV + c]); }
            if (F.tid < 32) { gts[F.tid] = IG[(size_t)bh * SEQ + s0 + F.tid]; gts[32 + F.tid] = LFp[(size_t)bh * SEQ + s0 + F.tid]; }
            LDS_WAIT(); __syncthreads();
            if (F.tid <= 256) {
                for (int t = 0; t < 32; ++t) {
                    const float ig = gts[t], lf = gts[32 + t];
                    const float mn = fmaxf(lf + mrun, ig), fd = expf(lf + mrun - mn), ie = expf(ig - mn); mrun = mn;
                    const float sv = ie * (F.tid < 256 ? vs[t * 256 + F.tid] : 1.0f);
                    float num = 0.f;
                    const LAS f32x4* q4 = (const LAS f32x4*)(qs + t * 128); const LAS f32x4* k4 = (const LAS f32x4*)(ks + t * 128);
#pragma unroll
                    for (int k = 0; k < 32; ++k) { const f32x4 qq = q4[k], kk = k4[k];
                        C[4 * k + 0] = fd * C[4 * k + 0] + sv * kk.x; num += qq.x * C[4 * k + 0];
                        C[4 * k + 1] = fd * C[4 * k + 1] + sv * kk.y; num += qq.y * C[4 * k + 1];
                        C[4 * k + 2] = fd * C[4 * k + 2] + sv * kk.z; num += qq.z * C[4 * k + 2];
                        C[4 * k + 3] = fd * C[4 * k + 3] + sv * kk.w; num += qq.w * C[4 * k + 3]; }
                    nums[t * 257 + F.tid] = num;
                    if (F.tid == 256) ems[t] = expf(-mn);
                }
            }
            LDS_WAIT(); __syncthreads();
            for (int u = F.tid; u < 32 * 256; u += NWAVES * 64) { const int t = u >> 8, c = u & 255;
                const float den = fmaxf(fabsf(nums[t * 257 + 256]), ems[t]);
                HH[(size_t)(b * SEQ + s0 + t) * D + h * MV + c] = (bf16)f2bf(nums[t * 257 + c] / den); }
        }
        __syncthreads();
    }
}

__device__ __forceinline__ void attn_naive(Frame& F) {
    LAS float* Ks = (LAS float*)(F.lds);
    LAS float* Vs = Ks + 64 * 64;
    LAS float* Fs = Vs + 64 * 64;
    const bf16* Q = (const bf16*)(F.ws + WS_RP); const bf16* K = Q + (size_t)M * D; const bf16* V = K + (size_t)M * D; bf16* O = (bf16*)(F.ws + WS_RP);
    const float* F2 = (const float*)(F.ws + WS_F2);
    for (int u = blockIdx.x; u < BATCH * FH * (SEQ / 512); u += F.G) {
        const int bh = u / (SEQ / 512), qb = u % (SEQ / 512), b = bh / FH, h = bh % FH;
        const int t = qb * 512 + F.tid; const size_t rowq = (size_t)(b * SEQ + t) * D + h * FHD;
        float q[64], o[64];
#pragma unroll
        for (int d = 0; d < 64; ++d) { q[d] = bf2f(Q[rowq + d]); o[d] = 0.f; }
        const float ft = F2[(size_t)bh * SEQ + t];
        float mrun = -1e30f, l = 0.f;
        const int ntile = (qb * 512 + 512) / 64;
        for (int kt = 0; kt < ntile; ++kt) {
            __syncthreads();
            for (int e = F.tid; e < 64 * 64; e += NWAVES * 64) { const int j = e >> 6, d = e & 63; const size_t a = (size_t)(b * SEQ + kt * 64 + j) * D + h * FHD + d; Ks[e] = bf2f(K[a]); Vs[e] = bf2f(V[a]); }
            if (F.tid < 64) Fs[F.tid] = F2[(size_t)bh * SEQ + kt * 64 + F.tid];
            LDS_WAIT(); __syncthreads();
            for (int j = 0; j < 64; ++j) {
                if (kt * 64 + j <= t) {
                    float x = 0.f; const LAS f32x4* k4 = (const LAS f32x4*)(Ks + j * 64);
#pragma unroll
                    for (int d = 0; d < 16; ++d) { const f32x4 kk = k4[d]; x += q[4 * d] * kk.x + q[4 * d + 1] * kk.y + q[4 * d + 2] * kk.z + q[4 * d + 3] * kk.w; }
                    x += ft - Fs[j];
                    const float mn = fmaxf(mrun, x), al = exp2f(mrun - mn), p = exp2f(x - mn); mrun = mn; l = l * al + p;
                    const LAS f32x4* v4 = (const LAS f32x4*)(Vs + j * 64);
#pragma unroll
                    for (int d = 0; d < 16; ++d) { const f32x4 vv = v4[d]; o[4 * d] = o[4 * d] * al + p * vv.x; o[4 * d + 1] = o[4 * d + 1] * al + p * vv.y; o[4 * d + 2] = o[4 * d + 2] * al + p * vv.z; o[4 * d + 3] = o[4 * d + 3] * al + p * vv.w; }
                }
            }
        }
        const float rl = 1.0f / l;
#pragma unroll
        for (int d = 0; d < 64; ++d) O[rowq + d] = (bf16)f2bf(o[d] * rl);
        __syncthreads();
    }
}

constexpr int NPHASES = 17;
struct Args { const float* in[21]; float* out; unsigned char* ws; int ph_lo, ph_hi, use_bar, pad; };
__global__ void __launch_bounds__(NWAVES * 64, 2) yoco_fwd(Args args) {
    extern __shared__ __attribute__((aligned(16))) unsigned char lds[];
    Frame F;
    F.lds = (LAS unsigned char*)lds;
    F.MISC = (volatile LAS unsigned*)(F.lds + MISC_OFF);
    F.tid = threadIdx.x; F.lane = F.tid & 63; F.wave = __builtin_amdgcn_readfirstlane(F.tid >> 6);
    F.G = gridDim.x;
    F.ws = args.ws; F.out = args.out; F.ctl = (gu32*)(args.ws + WS_CTL);
    F.in = args.in;
    for (int u = F.tid; u < (LDS_BYTES - LDSCTL_OFF) / 4; u += NWAVES * 64) ((LAS unsigned*)(F.lds + LDSCTL_OFF))[u] = 0u;
    __syncthreads();
    XcdBarrier bar; bar.bar = (unsigned*)(F.ctl + CW_BAR); bar.x = 0; bar.st = nullptr;
    if (args.use_bar) bar = xcd_barrier_post((unsigned*)(F.ctl + CW_BAR), F.MISC + 8);

    const int lo = args.ph_lo, hi = args.ph_hi;
#define IN(k) (lo <= (k) && (k) < hi)
#define SEAM(k) do { if (IN(k) && (k) > lo) xcd_barrier(bar); } while (0)
#define WSP(off) (args.ws + (off))
#define MODP ((const float*)(args.ws + WS_MOD))
#define GEMM_BF16(Aoff, Boff, N_, K_, Ooff, ldc_, split_, stride_, scale_) do { \
        pg8::Gemm g{(const pg8::bf16_t*)WSP(Aoff), (const pg8::bf16_t*)WSP(Boff), M, (N_), (K_)}; pg8::StaticOrder S; S.init(M, (N_), F.G, (int)blockIdx.x); \
        pg8::EpiBf16 E{(pg8::bf16_t*)WSP(Ooff), (ldc_), (split_), (size_t)(stride_), (scale_)}; \
        pg8::gemm_phase<pg8::EpiBf16, pg8::StaticOrder, true, true>(F.lds + RING_OFF, g, S, E); } while (0)
#define GEMM_SWIGLU(Aoff, Boff, Ooff) do { \
        pg8::Gemm g{(const pg8::bf16_t*)WSP(Aoff), (const pg8::bf16_t*)WSP(Boff), M, 2 * DFF, D}; pg8::StaticOrder S; S.init(M, 2 * DFF, F.G, (int)blockIdx.x); \
        pg8::EpiSwiGLU E{(pg8::bf16_t*)WSP(Ooff), DFF}; \
        pg8::gemm_phase<pg8::EpiSwiGLU, pg8::StaticOrder, true, true>(F.lds + RING_OFF, g, S, E); } while (0)

    SEAM(0);  if (IN(0)) p0_prologue(F);
    SEAM(1);  if (IN(1)) row_phase_A(F);
    SEAM(2);  if (IN(2)) GEMM_BF16(WS_RA, WS_WA_IN, M_INP, D, WS_RP, M_INP, 0, 0, 1.f);
    SEAM(3);  if (IN(3)) mlstm_naive(F);
    SEAM(4);  if (IN(4)) row_phase_B(F);
    SEAM(5);  if (IN(5)) GEMM_BF16(WS_RA, WS_WA_OUT, D, D, WS_RD, D, 0, 0, 1.f);
    SEAM(6);  if (IN(6)) row_phase_C<0>(F, args.in[I_X], args.in[I_MIX_POST_G], MODP + 2048, args.in[I_FFN_PRE_G], MODP + 3072);
    SEAM(7);  if (IN(7)) GEMM_SWIGLU(WS_RA, WS_WFI, WS_RP);
    SEAM(8);  if (IN(8)) GEMM_BF16(WS_RP, WS_WFO, D, DFF, WS_RD, D, 0, 0, 1.f);
    SEAM(9);  if (IN(9)) row_phase_C<1>(F, args.out, args.in[I_FFN_POST_G], MODP + 5120, args.in[I_MIX_PRE_G] + 1024, MODP + (size_t)8 * 6144);
    SEAM(10); if (IN(10)) { cumsum_f2(F);
                            GEMM_BF16(WS_RB, WS_WKV, 2048, D, WS_RP + 64 * MiB, D, 1024, (size_t)M * D, 1.f);
                            GEMM_BF16(WS_RA, WS_WQ, D, D, WS_RP, D, 1024, 0, QSCALE2); }
    SEAM(11); if (IN(11)) attn_naive(F);
    SEAM(12); if (IN(12)) GEMM_BF16(WS_RP, WS_WBO, D, D, WS_RD, D, 0, 0, 1.f);
    SEAM(13); if (IN(13)) row_phase_C<0>(F, args.out, args.in[I_MIX_POST_G] + 1024, MODP + (size_t)8 * 6144 + 2048, args.in[I_FFN_PRE_G] + 1024, MODP + (size_t)8 * 6144 + 3072);
    SEAM(14); if (IN(14)) GEMM_SWIGLU(WS_RA, WS_WFI + WFI_STRIDE, WS_RP);
    SEAM(15); if (IN(15)) GEMM_BF16(WS_RP, WS_WFO + WFO_STRIDE, D, DFF, WS_RD, D, 0, 0, 1.f);
    SEAM(16); if (IN(16)) row_phase_C<2>(F, args.out, args.in[I_FFN_POST_G] + 1024, MODP + (size_t)8 * 6144 + 5120, nullptr, nullptr);
}

#ifndef MK_PER_PHASE
#define MK_PER_PHASE 1
#endif
extern "C" void kernel_launch(void* const* d_in, const int* in_sizes, int n_in, void* d_out, int out_size, void* d_ws, size_t ws_size, hipStream_t stream) {
    static int grid = 0;
    if (grid == 0) {
        if (n_in != 21 || in_sizes[0] != M * D || out_size != M * D || ws_size < WS_END) { fprintf(stderr, "kernel_launch: unexpected shapes: n_in %d in0 %d out %d ws %zu (need %zu)\n", n_in, n_in > 0 ? in_sizes[0] : -1, out_size, ws_size, (size_t)WS_END); grid = -1; return; }
        int dev = 0, cus = 0, per_cu = 0;
        if (hipGetDevice(&dev) != hipSuccess || hipDeviceGetAttribute(&cus, hipDeviceAttributeMultiprocessorCount, dev) != hipSuccess) { grid = -1; return; }
        if (hipFuncSetAttribute((const void*)yoco_fwd, hipFuncAttributeMaxDynamicSharedMemorySize, LDS_BYTES) != hipSuccess) { fprintf(stderr, "kernel_launch: hipFuncSetAttribute failed\n"); grid = -1; return; }
        if (hipOccupancyMaxActiveBlocksPerMultiprocessor(&per_cu, (const void*)yoco_fwd, NWAVES * 64, LDS_BYTES) != hipSuccess || per_cu < 1)
            fprintf(stderr, "kernel_launch: note: occupancy query reports %d workgroups per CU\n", per_cu);
        (void)hipGetLastError();
        grid = cus;
        if (grid != 256) { fprintf(stderr, "kernel_launch: built for 256 CUs, device has %d\n", grid); }
    }
    if (grid < 0) return;
    if (hipMemsetAsync((char*)d_ws + WS_CTL, 0, CTL_ZERO_BYTES, stream) != hipSuccess) { fprintf(stderr, "kernel_launch: hipMemsetAsync failed\n"); return; }
    Args a{};
    for (int i = 0; i < 21; ++i) a.in[i] = (const float*)d_in[i];
    a.out = (float*)d_out; a.ws = (unsigned char*)d_ws;
#if MK_PER_PHASE
    for (int ph = 0; ph < NPHASES; ++ph) {
        a.ph_lo = ph; a.ph_hi = ph + 1; a.use_bar = 0;
        hipLaunchKernelGGL(yoco_fwd, dim3(256), dim3(NWAVES * 64), LDS_BYTES, stream, a);
    }
#else
    a.ph_lo = 0; a.ph_hi = NPHASES; a.use_bar = 1;
    hipLaunchKernelGGL(yoco_fwd, dim3(256), dim3(NWAVES * 64), LDS_BYTES, stream, a);
#endif
    const hipError_t le = hipPeekAtLastError();
    if (le != hipSuccess) fprintf(stderr, "kernel_launch: launch failed: %s\n", hipGetErrorName(le));
}
```

```cpp
#include <hip/hip_runtime.h>
#include <hip/hip_bf16.h>
#include <cstdio>
#include <cstdint>
#include <cmath>
namespace pg8 {
#define PG8_LAS __attribute__((address_space(3)))
typedef unsigned short bf16_t;
typedef short bf16x8 __attribute__((ext_vector_type(8)));
typedef float f32x4 __attribute__((ext_vector_type(4)));
typedef unsigned u32x4 __attribute__((ext_vector_type(4)));
constexpr int BM = 256, BK = 64, HALF = 128, HTB = HALF * BK * 2  , STAGE_BYTES = 8 * HTB, NXCD = 8, WGM = 8;

__host__ __device__ __forceinline__ int lds_byte(int r, int c) { const int st = (r >> 4) * 2 + (c >> 5), rr = r & 15, cc = c & 31, ob = rr * 64 + cc * 2; return st * 1024 + (ob ^ (((ob >> 9) & 1) << 5)); }
__host__ __device__ __forceinline__ void stage_rc(int b, int& R, int& C) { const int st = b / 1024, sb = b % 1024, swz = sb ^ (((sb >> 9) & 1) << 5); R = (st >> 1) * 16 + swz / 64; C = (st & 1) * 32 + (swz % 64) / 2; }
__host__ __device__ __forceinline__ int perm32(int rho) { const int n = rho >> 4, i = rho & 15; return 8 * (i >> 2) + 4 * n + (i & 3); }

struct Unit { int pm, pn; };
struct Gemm { const bf16_t* A; const bf16_t* Bt; int M, N, K; };

struct StaticOrder {
    int nM, nN, nwg, G, c;
    __host__ __device__ void init(int M, int N, int G_, int c_) { nM = M / BM; nN = N / BM; nwg = nM * nN; G = G_; c = c_; }
    __host__ __device__ bool next(int i, Unit& u) const {
        const long L = (long)i * G + c; if (L >= nwg) return false;
        int wgid = (int)L; { const int q = nwg / NXCD, r = nwg % NXCD, xcd = wgid % NXCD, off = wgid / NXCD; wgid = (xcd < r ? xcd * (q + 1) : r * (q + 1) + (xcd - r) * q) + off; }
        const int nig = WGM * nN, gid = wgid / nig, fm = gid * WGM, gsz = (nM - fm) < WGM ? (nM - fm) : WGM;
        u.pm = fm + ((wgid % nig) % gsz); u.pn = (wgid % nig) / gsz; return true;
    }
    __device__ __forceinline__ void a_ready(const Unit&) const {}
    __device__ __forceinline__ void done(const Unit&) const {}
};

__device__ __forceinline__ unsigned cvt_pk_bf16(float lo, float hi) { unsigned r; asm volatile("v_cvt_pk_bf16_f32 %0, %1, %2" : "=v"(r) : "v"(lo), "v"(hi)); return r; }
struct EpiBf16 {
    static constexpr bool PERM = true, AFTER_DRAIN = false;
    bf16_t* O; int ldc; int split_cols; size_t split_stride; float scale0;
    __device__ __forceinline__ void operator()(const f32x4 (&acc)[2][2][4][2], const Unit& u, int wr, int wc, int fr, int fq) const {
        const int row0 = u.pm * BM + wr * 64 + fr; int colt = u.pn * BM; bf16_t* base = O;
        float sc = 1.f; if (split_cols) { const int t = colt / split_cols; base += (size_t)t * split_stride; colt -= t * split_cols; if (t == 0) sc = scale0; }
        const int col0 = colt + wc * 32 + 8 * fq;
#pragma unroll
        for (int ai = 0; ai < 2; ++ai)
#pragma unroll
            for (int m = 0; m < 4; ++m) { bf16_t* rowp = base + (size_t)(row0 + ai * HALF + m * 16) * ldc + col0;
#pragma unroll
                for (int bj = 0; bj < 2; ++bj) { f32x4 v0 = acc[ai][bj][m][0], v1 = acc[ai][bj][m][1];
                    v0 = v0 * sc; v1 = v1 * sc; u32x4 w; w.x = cvt_pk_bf16(v0[0], v0[1]); w.y = cvt_pk_bf16(v0[2], v0[3]); w.z = cvt_pk_bf16(v1[0], v1[1]); w.w = cvt_pk_bf16(v1[2], v1[3]);
                    *(u32x4*)(rowp + bj * HALF) = w; } }
    }
};
__device__ __forceinline__ float silu_mul(float g, float u) { return g * u * __builtin_amdgcn_rcpf(1.0f + __builtin_amdgcn_exp2f(-1.4426950408889634f * g)); }
struct EpiSwiGLU {
    static constexpr bool PERM = true, AFTER_DRAIN = false;
    bf16_t* O; int ldc;
    __device__ __forceinline__ void operator()(const f32x4 (&acc)[2][2][4][2], const Unit& u, int wr, int wc, int fr, int fq) const {
        const int row0 = u.pm * BM + wr * 64 + fr; const int col0 = u.pn * HALF + wc * 32 + 8 * fq;
#pragma unroll
        for (int ai = 0; ai < 2; ++ai)
#pragma unroll
            for (int m = 0; m < 4; ++m) { bf16_t* rowp = O + (size_t)(row0 + ai * HALF + m * 16) * ldc + col0;
                const f32x4 g0 = acc[ai][0][m][0], g1 = acc[ai][0][m][1], u0 = acc[ai][1][m][0], u1 = acc[ai][1][m][1];
                u32x4 w; w.x = cvt_pk_bf16(silu_mul(g0[0], u0[0]), silu_mul(g0[1], u0[1])); w.y = cvt_pk_bf16(silu_mul(g0[2], u0[2]), silu_mul(g0[3], u0[3]));
                w.z = cvt_pk_bf16(silu_mul(g1[0], u1[0]), silu_mul(g1[1], u1[1])); w.w = cvt_pk_bf16(silu_mul(g1[2], u1[2]), silu_mul(g1[3], u1[3]));
                *(u32x4*)rowp = w; }
    }
};

template <class Epi, class Sched, bool ALIGN_EPI = false, bool SP2 = false>
__device__ __forceinline__ void gemm_phase(PG8_LAS unsigned char* lds, const Gemm g, const Sched& S, const Epi& E) {
    const int tid = threadIdx.x, wid = __builtin_amdgcn_readfirstlane(tid >> 6), lane = tid & 63, wr = wid >> 2, wc = wid & 3, fr = lane & 15, fq = lane >> 4;
    const int K = g.K, nt = K / BK;
    unsigned voffA[2], voffB[2];
#pragma unroll
    for (int i = 0; i < 2; ++i) { int R, C; stage_rc(tid * 16 + i * 8192, R, C); const int Rb = Epi::PERM ? ((R & ~31) + perm32(R & 31)) : R;
        voffA[i] = (unsigned)(R * K + C) * 2u; voffB[i] = (unsigned)(Rb * K + C) * 2u; }
    const size_t kstep = (size_t)(BK * 2);
    const size_t hstep = (size_t)HALF * K * 2;
    const size_t tstep = 2 * hstep;
    const unsigned ldsw = (unsigned)wid * 1024u;
    const int aoff = lds_byte(wr * 64 + fr, fq * 8), boff = lds_byte(wc * 32 + fr, fq * 8);
#define PG8_SA(b, h) (((b) * 2 + (h)) * HTB)
#define PG8_SB(b, h) ((4 + (b) * 2 + (h)) * HTB)
#define PG8_STAGE(bufoff, gbase, voff) do { _Pragma("unroll") for (int _i = 0; _i < 2; ++_i) \
        __builtin_amdgcn_global_load_lds((const unsigned*)((const char*)(gbase) + (voff)[_i]), (PG8_LAS unsigned*)(lds + (bufoff) + ldsw + _i * 8192), 16, 0, 0); } while (0)
#define PG8_LDA(dst, b, h) do { _Pragma("unroll") for (int m = 0; m < 4; ++m) _Pragma("unroll") for (int k = 0; k < 2; ++k) dst[m][k] = *(const PG8_LAS bf16x8*)(lds + PG8_SA(b, h) + aoff + m * 2048 + k * 1024); } while (0)
#define PG8_LDB(dst, b, h) do { _Pragma("unroll") for (int n = 0; n < 2; ++n) _Pragma("unroll") for (int k = 0; k < 2; ++k) dst[n][k] = *(const PG8_LAS bf16x8*)(lds + PG8_SB(b, h) + boff + n * 2048 + k * 1024); } while (0)
#define PG8_MMA(ai, bj, At, Bt) do { __builtin_amdgcn_s_setprio(1); _Pragma("unroll") for (int m = 0; m < 4; ++m) _Pragma("unroll") for (int n = 0; n < 2; ++n) _Pragma("unroll") for (int k = 0; k < 2; ++k) \
        acc[ai][bj][m][n] = __builtin_amdgcn_mfma_f32_16x16x32_bf16(Bt[n][k], At[m][k], acc[ai][bj][m][n], 0, 0, 0); __builtin_amdgcn_s_setprio(0); } while (0)
#define PG8_WAIT_V(n) asm volatile("s_waitcnt vmcnt(" #n ")" ::: "memory")
#define PG8_WAIT_L(n) asm volatile("s_waitcnt lgkmcnt(" #n ")" ::: "memory")
#define PG8_BAR __builtin_amdgcn_s_barrier()
#define PG8_SCHED __builtin_amdgcn_sched_barrier(0)
    Unit cur, nxt; int ui = 0;
    if (!S.next(0, cur)) return;
    f32x4 acc[2][2][4][2];
#pragma unroll
    for (int a = 0; a < 2; ++a)
#pragma unroll
        for (int b = 0; b < 2; ++b)
#pragma unroll
            for (int m = 0; m < 4; ++m)
#pragma unroll
                for (int n = 0; n < 2; ++n) acc[a][b][m][n] = (f32x4){0.f, 0.f, 0.f, 0.f};
    bf16x8 At[4][2], B0[2][2], B1[2][2];
    const char* cA = (const char*)g.A + (size_t)cur.pm * tstep; const char* cB = (const char*)g.Bt + (size_t)cur.pn * tstep;
    S.a_ready(cur);
    if constexpr (SP2) {
        PG8_STAGE(PG8_SB(0, 0), cB, voffB); PG8_STAGE(PG8_SB(0, 1), cB + hstep, voffB); PG8_STAGE(PG8_SA(0, 0), cA, voffA); PG8_STAGE(PG8_SA(0, 1), cA + hstep, voffA);
        if (wr == 1) PG8_BAR;
        PG8_WAIT_V(2); PG8_BAR;
        PG8_STAGE(PG8_SB(1, 0), cB + kstep, voffB); PG8_STAGE(PG8_SA(1, 0), cA + kstep, voffA); PG8_STAGE(PG8_SB(1, 1), cB + hstep + kstep, voffB);
        PG8_WAIT_V(6); PG8_BAR;
    } else {
        PG8_STAGE(PG8_SB(0, 0), cB, voffB); PG8_STAGE(PG8_SA(0, 0), cA, voffA); PG8_STAGE(PG8_SB(0, 1), cB + hstep, voffB); PG8_STAGE(PG8_SA(0, 1), cA + hstep, voffA);
        if (wr == 1) PG8_BAR;
        PG8_WAIT_V(4); PG8_BAR;
        PG8_STAGE(PG8_SB(1, 0), cB + kstep, voffB); PG8_STAGE(PG8_SA(1, 0), cA + kstep, voffA); PG8_STAGE(PG8_SB(1, 1), cB + hstep + kstep, voffB);
        PG8_WAIT_V(6); PG8_BAR;
    }
    for (;;) {
        const bool has_next = S.next(ui + 1, nxt);
        const char* nA = has_next ? (const char*)g.A + (size_t)nxt.pm * tstep : cA; const char* nB = has_next ? (const char*)g.Bt + (size_t)nxt.pn * tstep : cB;
        for (int t = 0; t < nt; t += 2) {
            const bool last = (t == nt - 2);
            const char* a1 = cA + (size_t)(t + 1) * kstep;
            const char* a2 = last ? nA : cA + (size_t)(t + 2) * kstep; const char* b2 = last ? nB : cB + (size_t)(t + 2) * kstep;
            const char* a3 = a2 + kstep; const char* b3 = b2 + kstep;
            if (last && has_next) S.a_ready(nxt);
            if constexpr (SP2) {
            PG8_LDB(B0, 0, 0); PG8_LDB(B1, 0, 1); PG8_SCHED; PG8_LDA(At, 0, 0); PG8_STAGE(PG8_SA(1, 1), a1 + hstep, voffA);
            PG8_WAIT_V(8); PG8_WAIT_L(0); PG8_BAR; PG8_MMA(0, 0, At, B0); PG8_MMA(0, 1, At, B1); PG8_BAR; PG8_SCHED;
            PG8_LDA(At, 0, 1); PG8_STAGE(PG8_SB(0, 0), b2, voffB); PG8_STAGE(PG8_SB(0, 1), b2 + hstep, voffB); PG8_STAGE(PG8_SA(0, 0), a2, voffA);
            PG8_WAIT_V(8); PG8_WAIT_L(0); PG8_BAR; PG8_MMA(1, 0, At, B0); PG8_MMA(1, 1, At, B1); PG8_BAR; PG8_SCHED;
            PG8_LDB(B0, 1, 0); PG8_LDB(B1, 1, 1); PG8_SCHED; PG8_LDA(At, 1, 0); PG8_STAGE(PG8_SA(0, 1), a2 + hstep, voffA);
            PG8_WAIT_V(8); PG8_WAIT_L(0); PG8_BAR; PG8_MMA(0, 0, At, B0); PG8_MMA(0, 1, At, B1); PG8_BAR; PG8_SCHED;
            PG8_LDA(At, 1, 1); PG8_STAGE(PG8_SB(1, 0), b3, voffB); PG8_STAGE(PG8_SB(1, 1), b3 + hstep, voffB); PG8_STAGE(PG8_SA(1, 0), a3, voffA);
            PG8_WAIT_V(8); PG8_WAIT_L(0); PG8_BAR; PG8_MMA(1, 0, At, B0); PG8_MMA(1, 1, At, B1); PG8_BAR; PG8_SCHED;
            } else {
            PG8_LDB(B0, 0, 0); PG8_SCHED; PG8_LDA(At, 0, 0); PG8_STAGE(PG8_SA(1, 1), a1 + hstep, voffA);
            PG8_WAIT_L(8); PG8_BAR; PG8_WAIT_L(0); PG8_MMA(0, 0, At, B0); PG8_BAR; PG8_SCHED;
            PG8_LDB(B1, 0, 1); PG8_STAGE(PG8_SB(0, 0), b2, voffB);
            PG8_BAR; PG8_WAIT_L(0); PG8_MMA(0, 1, At, B1); PG8_BAR;
            PG8_LDA(At, 0, 1); PG8_STAGE(PG8_SA(0, 0), a2, voffA);
            PG8_BAR; PG8_WAIT_L(0); PG8_MMA(1, 0, At, B0); PG8_BAR; PG8_SCHED;
            PG8_STAGE(PG8_SB(0, 1), b2 + hstep, voffB);
            PG8_WAIT_V(6); PG8_BAR; PG8_MMA(1, 1, At, B1); PG8_BAR;
            PG8_LDB(B0, 1, 0); PG8_SCHED; PG8_LDA(At, 1, 0); PG8_STAGE(PG8_SA(0, 1), a2 + hstep, voffA);
            PG8_WAIT_L(8); PG8_BAR; PG8_WAIT_L(0); PG8_MMA(0, 0, At, B0); PG8_BAR; PG8_SCHED;
            PG8_LDB(B1, 1, 1); PG8_STAGE(PG8_SB(1, 0), b3, voffB);
            PG8_BAR; PG8_WAIT_L(0); PG8_MMA(0, 1, At, B1); PG8_BAR;
            PG8_LDA(At, 1, 1); PG8_STAGE(PG8_SA(1, 0), a3, voffA);
            PG8_BAR; PG8_WAIT_L(0); PG8_MMA(1, 0, At, B0); PG8_BAR; PG8_SCHED;
            PG8_STAGE(PG8_SB(1, 1), b3 + hstep, voffB);
            PG8_WAIT_V(6); PG8_BAR; PG8_MMA(1, 1, At, B1); PG8_BAR;
            }
        }
        if constexpr (ALIGN_EPI) { if (wr == 0) PG8_BAR; }
        if constexpr (!Epi::AFTER_DRAIN) { E(acc, cur, wr, wc, fr, fq); S.done(cur); }
        if (!has_next) break;
#pragma unroll
        for (int a = 0; a < 2; ++a)
#pragma unroll
            for (int b = 0; b < 2; ++b)
#pragma unroll
                for (int m = 0; m < 4; ++m)
#pragma unroll
                    for (int n = 0; n < 2; ++n) acc[a][b][m][n] = (f32x4){0.f, 0.f, 0.f, 0.f};
        cur = nxt; cA = nA; cB = nB; ++ui;
        if constexpr (ALIGN_EPI) { if (wr == 1) PG8_BAR; }
    }
    PG8_WAIT_V(0);
    if constexpr (!ALIGN_EPI) { if (wr == 0) PG8_BAR; }
    PG8_BAR;
    if constexpr (Epi::AFTER_DRAIN) { E.fused(acc, cur, wr, wc, fr, fq, lds, wid, lane); S.done(cur); }
#undef PG8_SA
#undef PG8_SB
#undef PG8_STAGE
#undef PG8_LDA
#undef PG8_LDB
#undef PG8_MMA
#undef PG8_WAIT_V
#undef PG8_WAIT_L
#undef PG8_BAR
#undef PG8_SCHED
}
}
#define GAS __attribute__((address_space(1)))
#define LAS __attribute__((address_space(3)))
typedef unsigned short bf16;
typedef unsigned v4u __attribute__((ext_vector_type(4)));
typedef float f32x4 __attribute__((ext_vector_type(4)));
typedef short bf16x8 __attribute__((ext_vector_type(8)));
typedef GAS unsigned gu32;
typedef GAS unsigned long long gu64;
#define RLX_AGENT __ATOMIC_RELAXED, __HIP_MEMORY_SCOPE_AGENT
#define LDS_WAIT() asm volatile("s_waitcnt lgkmcnt(0)" ::: "memory")
#define VM_WAIT() asm volatile("s_waitcnt vmcnt(0)" ::: "memory")
__device__ __forceinline__ unsigned long long rt() { return __builtin_amdgcn_s_memrealtime(); }
__device__ __forceinline__ unsigned f2bf(float f) { unsigned u = __builtin_bit_cast(unsigned, f); return (u + 0x7fffu + ((u >> 16) & 1u)) >> 16; }
__device__ __forceinline__ unsigned pk2(float lo, float hi) { return f2bf(lo) | (f2bf(hi) << 16); }

#define XB_TMO      128
#define XB_XCNT(j)  (256  + 64 * (j))
#define XB_XSUB(j)  (1280 + 64 * (j))
#define XB_XGEN(j)  (2304 + 64 * (j))
#define XB_TOP      3328
#define XB_TOPGEN   3392
#define XCD_BAR_WORDS 3456
#define XB_SPIN_CAP (1u << 18)

__device__ __forceinline__ unsigned xb_ld(unsigned* p)              { return __hip_atomic_load(p, __ATOMIC_RELAXED, __HIP_MEMORY_SCOPE_AGENT); }
__device__ __forceinline__ unsigned xb_add(unsigned* p, unsigned v) { return __hip_atomic_fetch_add(p, v, __ATOMIC_RELAXED, __HIP_MEMORY_SCOPE_AGENT); }
__device__ __forceinline__ unsigned xb_xcc_id() { return (unsigned)__builtin_amdgcn_s_getreg((3 << 11) | 20) & 0xFu; }
#define XB_SPIN(cond, bar) do { unsigned _sp = 0; while (cond) { __builtin_amdgcn_s_sleep(1); \
    if ((++_sp & 255u) == 0u) { if (xb_ld(&(bar)[XB_TMO])) break; if (_sp > XB_SPIN_CAP) { atomicAdd(&(bar)[XB_TMO], 1u); break; } } } } while (0)

struct XcdBarrier {
    unsigned* bar; unsigned x;
    volatile LAS unsigned* st;
};

__device__ __forceinline__ XcdBarrier xcd_barrier_post(unsigned* bar, volatile LAS unsigned* st) {
    XcdBarrier b; b.bar = bar; b.x = xb_xcc_id(); b.st = st;
    if (threadIdx.x == 0) (void)xb_add(&bar[XB_XCNT(b.x)], 1u);
    return b;
}
__device__ __forceinline__ void xcd_barrier_complete(unsigned* bar, unsigned x, unsigned& nloc, unsigned& nx) {
    const unsigned G = gridDim.x * gridDim.y * gridDim.z;
    unsigned sum, cnt, mine, sp = 0u;
    for (;;) {
        sum = 0u; cnt = 0u; mine = 0u;
#pragma unroll
        for (unsigned j = 0; j < 16; ++j) { const unsigned c = xb_ld(&bar[XB_XCNT(j)]); sum += c; cnt += (c > 0u) ? 1u : 0u; mine = (j == x) ? c : mine; }
        if (sum == G) break;
        __builtin_amdgcn_s_sleep(1);
        if ((++sp & 255u) == 0u) { if (xb_ld(&bar[XB_TMO])) break; if (sp > XB_SPIN_CAP) { atomicAdd(&bar[XB_TMO], 1u); break; } }
    }
    nloc = mine > 0u ? mine : 1u; nx = cnt > 0u ? cnt : 1u;
}

__device__ __forceinline__ void xcd_barrier(const XcdBarrier& b) {
    asm volatile("s_waitcnt vmcnt(0)" ::: "memory");
    __syncthreads();
    if (threadIdx.x == 0) {
        unsigned* bar = b.bar;
        __builtin_amdgcn_s_waitcnt(0);
        unsigned nloc = b.st[0], nx = b.st[1];
        if (nloc == 0u) { xcd_barrier_complete(bar, b.x, nloc, nx); b.st[0] = nloc; b.st[1] = nx; }
        const unsigned old = xb_add(&bar[XB_XSUB(b.x)], 1u);
        const unsigned gen = old / nloc;
        if (old + 1u == (gen + 1u) * nloc) {
            __builtin_amdgcn_fence(__ATOMIC_RELEASE, "agent");
            asm volatile("s_waitcnt vmcnt(0)" ::: "memory");
            const unsigned og = xb_add(&bar[XB_TOP], 1u);
            const unsigned tg = og / nx;
            if (og + 1u == (tg + 1u) * nx) xb_add(&bar[XB_TOPGEN], 1u);
            else XB_SPIN(xb_ld(&bar[XB_TOPGEN]) == tg, bar);
            __builtin_amdgcn_fence(__ATOMIC_ACQUIRE, "agent");
            xb_add(&bar[XB_XGEN(b.x)], 1u);
            asm volatile("s_waitcnt vmcnt(0)" ::: "memory");
        } else {
            XB_SPIN(xb_ld(&bar[XB_XGEN(b.x)]) == gen, bar);
            __builtin_amdgcn_fence(__ATOMIC_ACQUIRE, "agent");
            asm volatile("s_waitcnt vmcnt(0)" ::: "memory");
        }
    }
    __syncthreads();
}
constexpr int NWAVES = 8;
constexpr int BATCH = 8, SEQ = 4096, D = 1024, M = BATCH * SEQ;
constexpr int MH = 4, MQK = 128, MV = 256, M_IN = 3080, M_INP = 3072;
constexpr int FH = 16, FHD = 64, KV_OUT = 2064;
constexpr int DFF = 2816;
constexpr float EPS = 1e-6f, GATE_CAP = 15.0f;
constexpr float LOG2E = 1.4426950408889634f;
constexpr float QSCALE2 = 0.125f * LOG2E;

constexpr size_t MiB = 1u << 20;
constexpr size_t WS_CTL = 0, CTL_ZERO_BYTES = 1 * MiB;
constexpr size_t WS_MOD = 1 * MiB;
constexpr size_t WS_IG = 2 * MiB, WS_LF = 2 * MiB + 512 * 1024;
constexpr size_t WS_LOGF = 3 * MiB, WS_F2 = 5 * MiB;
constexpr size_t WS_WA_IN = 8 * MiB, WS_WA_OUT = 14 * MiB, WS_WKV = 16 * MiB, WS_WQ = 20 * MiB, WS_WBO = 22 * MiB;
constexpr size_t WS_WFI = 24 * MiB, WFI_STRIDE = 11 * MiB;
constexpr size_t WS_WFO = 46 * MiB, WFO_STRIDE = 5632 * 1024;
constexpr size_t WS_RA = 64 * MiB, WS_RB = 128 * MiB, WS_RD = 192 * MiB, WS_RP = 256 * MiB, WS_END = 448 * MiB;
constexpr int CW_BAR = 4096;

constexpr int RING_OFF = 0, RING_BYTES = 131072;
constexpr int LDSCTL_OFF = RING_BYTES, MISC_OFF = LDSCTL_OFF + 320;
constexpr int LDS_BYTES = 147456;

typedef GAS f32x4 gf32x4;
typedef unsigned u32x2 __attribute__((ext_vector_type(2)));
__device__ __forceinline__ float bf2f(unsigned short h) { return __builtin_bit_cast(float, (unsigned)h << 16); }
__device__ __forceinline__ float bflo(unsigned w) { return __builtin_bit_cast(float, w << 16); }
__device__ __forceinline__ float bfhi(unsigned w) { return __builtin_bit_cast(float, w & 0xffff0000u); }

struct Frame {
    LAS unsigned char* lds;
    volatile LAS unsigned* MISC;
    gu32* ctl;
    int tid, lane, wave, G;
    const float* const* in; float* out; unsigned char* ws;
};
enum { I_X = 0, I_C, I_MOD_W, I_MOD_B, I_MIX_PRE_G, I_MIX_POST_G, I_FFN_PRE_G, I_FFN_POST_G, I_FFN_W_IN, I_FFN_W_OUT, I_A_W_IN, I_A_GATE_B, I_A_HNORM_G, I_A_W_OUT,
       I_KV_NORM_G, I_KV_MOD_W, I_KV_MOD_B, I_KV_W, I_KV_FGATE_B, I_B_W_Q, I_B_W_OUT };

__device__ __forceinline__ float wave_sum(float v) {
#pragma unroll
    for (int o = 1; o < 64; o <<= 1) v += __shfl_xor(v, o);
    return v;
}
__device__ __forceinline__ float dot4(f32x4 a, f32x4 b) { return (a.x * b.x + a.y * b.y) + (a.z * b.z + a.w * b.w); }
__device__ __forceinline__ float softcapf(float a) { return GATE_CAP * tanhf(a * (1.0f / GATE_CAP)); }
__device__ __forceinline__ float logsigf(float x) { return fminf(x, 0.f) - log1pf(expf(-fabsf(x))); }

__device__ __forceinline__ void ld_row_f32(const float* p, int lane, f32x4 (&v)[4]) {
    const gf32x4* xr = (const gf32x4*)p + lane;
#pragma unroll
    for (int j = 0; j < 4; ++j) v[j] = xr[64 * j];
}
__device__ __forceinline__ void st_row_f32(float* p, int lane, const f32x4 (&v)[4]) {
    gf32x4* xr = (gf32x4*)p + lane;
#pragma unroll
    for (int j = 0; j < 4; ++j) xr[64 * j] = v[j];
}
__device__ __forceinline__ void ld_row_bf16(const bf16* p, int lane, f32x4 (&v)[4]) {
    const GAS u32x2* xr = (const GAS u32x2*)p + lane;
#pragma unroll
    for (int j = 0; j < 4; ++j) { const u32x2 w = xr[64 * j]; v[j] = (f32x4){bflo(w.x), bfhi(w.x), bflo(w.y), bfhi(w.y)}; }
}
__device__ __forceinline__ void st_row_bf16(bf16* p, int lane, const f32x4 (&v)[4]) {
    GAS u32x2* xr = (GAS u32x2*)p + lane;
#pragma unroll
    for (int j = 0; j < 4; ++j) { u32x2 w; w.x = pk2(v[j].x, v[j].y); w.y = pk2(v[j].z, v[j].w); xr[64 * j] = w; }
}
__device__ __forceinline__ float row_sumsq(const f32x4 (&v)[4]) {
    float s = 0.f;
#pragma unroll
    for (int j = 0; j < 4; ++j) s += dot4(v[j], v[j]);
    return wave_sum(s);
}

__device__ __forceinline__ void p0_transpose_item(const float* W, int K, int ldn, int c0, int k0, bf16* WT, int r0, LAS float* scr, int lane) {
#pragma unroll 8
    for (int i = 0; i < 32; ++i) { const int kk = 2 * i + (lane >> 5); scr[kk * 33 + (lane & 31)] = W[(size_t)(k0 + kk) * ldn + c0 + (lane & 31)]; }
    LDS_WAIT(); asm volatile("" ::: "memory");
    const int c = lane & 7;
#pragma unroll
    for (int j = 0; j < 4; ++j) { const int n = (lane >> 3) + 8 * j; const LAS float* s = scr + (8 * c) * 33 + n;
        v4u o; o.x = pk2(s[0 * 33], s[1 * 33]); o.y = pk2(s[2 * 33], s[3 * 33]); o.z = pk2(s[4 * 33], s[5 * 33]); o.w = pk2(s[6 * 33], s[7 * 33]);
        *(GAS v4u*)(WT + (size_t)(r0 + n) * K + k0 + 8 * c) = o; }
    LDS_WAIT(); asm volatile("" ::: "memory");
}
__device__ __forceinline__ bool p0_matrix(int& r, const float* W, int K, int ldn, int ncols, bf16* WT, int swiglu, LAS float* scr, int lane) {
    const int ncb = ncols / 32, nit = (K / 64) * ncb;
    if (r >= nit) { r -= nit; return false; }
    const int kb = r / ncb, cb = r % ncb, c0 = 32 * cb;
    int r0 = c0;
    if (swiglu) { const int isu = c0 >= DFF ? 1 : 0, j = c0 - isu * DFF; r0 = (j >> 7) * 256 + isu * 128 + (j & 127); }
    p0_transpose_item(W, K, ldn, c0, 64 * kb, WT, r0, scr, lane);
    return true;
}
__device__ __forceinline__ void p0_prologue(Frame& F) {
    const int gw = blockIdx.x * NWAVES + F.wave, NGW = F.G * NWAVES;
    {
        LAS float* csL = (LAS float*)(F.lds);
        LAS float* part = (LAS float*)(F.lds + 32768);
        for (int u = F.tid; u < 8 * 1024; u += NWAVES * 64) { const float c = F.in[I_C][u]; csL[u] = c / (1.0f + expf(-c)); }
        LDS_WAIT(); __syncthreads();
        float* MOD = (float*)(F.ws + WS_MOD);
        for (int it = blockIdx.x; it < 224; it += F.G) {
            const float* W; const float* bias; float* out; int N, n0;
            if (it < 192) { const int l = it / 96; N = 6144; n0 = 64 * (it % 96); W = F.in[I_MOD_W] + (size_t)l * 1024 * 6144; bias = F.in[I_MOD_B] + l * 6144; out = MOD + (size_t)l * 8 * 6144; }
            else { N = 2048; n0 = 64 * (it - 192); W = F.in[I_KV_MOD_W]; bias = F.in[I_KV_MOD_B]; out = MOD + (size_t)2 * 8 * 6144; }
            float acc[8];
#pragma unroll
            for (int b = 0; b < 8; ++b) acc[b] = 0.f;
            const int kbeg = 128 * F.wave;
#pragma unroll 8
            for (int k = 0; k < 128; ++k) { const float w = W[(size_t)(kbeg + k) * N + n0 + F.lane];
#pragma unroll
                for (int b = 0; b < 8; ++b) acc[b] += csL[b * 1024 + kbeg + k] * w; }
#pragma unroll
            for (int b = 0; b < 8; ++b) part[(F.wave * 8 + b) * 64 + F.lane] = acc[b];
            LDS_WAIT(); __syncthreads();
            { const int b = F.wave; float s = bias[n0 + F.lane];
#pragma unroll
              for (int w = 0; w < 8; ++w) s += part[(w * 8 + b) * 64 + F.lane];
              out[(size_t)b * N + n0 + F.lane] = s; }
            LDS_WAIT(); __syncthreads();
        }
        __syncthreads();
    }
    LAS float* scr = (LAS float*)(F.lds + RING_OFF + F.wave * 16384);
    constexpr int NITEMS = 16 * 96 + 16 * 32 + 16 * 64 + 16 * 32 + 16 * 32 + 2 * (16 * 176) + 2 * (44 * 32);
    for (int it = gw; it < NITEMS; it += NGW) {
        int r = it;
        if (p0_matrix(r, F.in[I_A_W_IN], 1024, M_IN, M_INP, (bf16*)(F.ws + WS_WA_IN), 0, scr, F.lane)) continue;
        if (p0_matrix(r, F.in[I_A_W_OUT], 1024, 1024, 1024, (bf16*)(F.ws + WS_WA_OUT), 0, scr, F.lane)) continue;
        if (p0_matrix(r, F.in[I_KV_W], 1024, KV_OUT, 2048, (bf16*)(F.ws + WS_WKV), 0, scr, F.lane)) continue;
        if (p0_matrix(r, F.in[I_B_W_Q], 1024, 1024, 1024, (bf16*)(F.ws + WS_WQ), 0, scr, F.lane)) continue;
        if (p0_matrix(r, F.in[I_B_W_OUT], 1024, 1024, 1024, (bf16*)(F.ws + WS_WBO), 0, scr, F.lane)) continue;
        if (p0_matrix(r, F.in[I_FFN_W_IN], 1024, 2 * DFF, 2 * DFF, (bf16*)(F.ws + WS_WFI), 1, scr, F.lane)) continue;
        if (p0_matrix(r, F.in[I_FFN_W_IN] + (size_t)1024 * 2 * DFF, 1024, 2 * DFF, 2 * DFF, (bf16*)(F.ws + WS_WFI + WFI_STRIDE), 1, scr, F.lane)) continue;
        if (p0_matrix(r, F.in[I_FFN_W_OUT], DFF, 1024, 1024, (bf16*)(F.ws + WS_WFO), 0, scr, F.lane)) continue;
        p0_matrix(r, F.in[I_FFN_W_OUT] + (size_t)DFF * 1024, DFF, 1024, 1024, (bf16*)(F.ws + WS_WFO + WFO_STRIDE), 0, scr, F.lane);
    }
}

constexpr int ROWS_PER_WAVE = 16;
static_assert(M == 256 * NWAVES * ROWS_PER_WAVE, "row phases assume a 256-workgroup grid");

__device__ __forceinline__ void ld_par(const float* p, int lane, f32x4 (&v)[4]) { ld_row_f32(p, lane, v); }

__device__ __forceinline__ void stage_gate_w(Frame& F, const float* W, int ldn, int c0, int ncol) {
    LAS float* T = (LAS float*)F.lds;
    for (int u = F.tid; u < ncol * 1024; u += NWAVES * 64) { const int k = u / ncol, c = u % ncol; T[c * 1024 + k] = W[(size_t)k * ldn + c0 + c]; }
    LDS_WAIT(); __syncthreads();
}
__device__ __forceinline__ float gate_dot(Frame& F, const f32x4 (&h)[4], int c) {
    const LAS f32x4* T = (const LAS f32x4*)(F.lds) + c * 256 + F.lane;
    float s = 0.f;
#pragma unroll
    for (int j = 0; j < 4; ++j) s += dot4(h[j], T[64 * j]);
    return s;
}

__device__ __forceinline__ void row_phase_A(Frame& F) {
    stage_gate_w(F, F.in[I_A_W_IN], M_IN, M_INP, 8);
    const int gw = blockIdx.x * NWAVES + F.wave, m0 = gw * ROWS_PER_WAVE, b = m0 / SEQ, lane = F.lane;
    const float* mod = (const float*)(F.ws + WS_MOD) + (size_t)b * 6144;
    f32x4 gs[4], sh[4];
    { f32x4 g[4], sc[4]; ld_par(F.in[I_MIX_PRE_G], lane, g); ld_par(mod + 1024, lane, sc); ld_par(mod, lane, sh);
#pragma unroll
      for (int j = 0; j < 4; ++j) gs[j] = g[j] * (sc[j] + 1.0f); }
    bf16* XN = (bf16*)(F.ws + WS_RA);
    float* IG = (float*)(F.ws + WS_IG); float* LFp = (float*)(F.ws + WS_LF);
    const float gb = F.in[I_A_GATE_B][lane & 7];
    for (int i = 0; i < ROWS_PER_WAVE; ++i) {
        const int m = m0 + i, s = m - b * SEQ;
        f32x4 v[4]; ld_row_f32(F.in[I_X] + (size_t)m * D, lane, v);
        const float r = 1.0f / sqrtf(row_sumsq(v) * (1.0f / D) + EPS);
#pragma unroll
        for (int j = 0; j < 4; ++j) v[j] = v[j] * r * gs[j] + sh[j];
        st_row_bf16(XN + (size_t)m * D, lane, v);
        float mine = 0.f;
#pragma unroll 1
        for (int c = 0; c < 8; ++c) { const float t = wave_sum(gate_dot(F, v, c)); if (lane == c) mine = t; }
        if (lane < 8) { const float a = softcapf(mine + gb);
            if (lane < 4) IG[(size_t)(b * MH + lane) * SEQ + s] = a; else LFp[(size_t)(b * MH + lane - 4) * SEQ + s] = logsigf(a); }
    }
    __syncthreads();
}
__device__ __forceinline__ void row_phase_B(Frame& F) {
    const int gw = blockIdx.x * NWAVES + F.wave, m0 = gw * ROWS_PER_WAVE, lane = F.lane;
    f32x4 hg[4]; ld_par(F.in[I_A_HNORM_G], lane, hg);
    const bf16* HH = (const bf16*)(F.ws + WS_RB); const bf16* PROJ = (const bf16*)(F.ws + WS_RP); bf16* Y = (bf16*)(F.ws + WS_RA);
    for (int i = 0; i < ROWS_PER_WAVE; ++i) {
        const int m = m0 + i;
        f32x4 v[4], o[4]; ld_row_bf16(HH + (size_t)m * D, lane, v); ld_row_bf16(PROJ + (size_t)m * M_INP + 2048, lane, o);
#pragma unroll
        for (int j = 0; j < 4; ++j) { const float r = 1.0f / sqrtf(wave_sum(dot4(v[j], v[j])) * (1.0f / MV) + EPS);
            f32x4 sg; sg.x = 1.0f / (1.0f + expf(-o[j].x)); sg.y = 1.0f / (1.0f + expf(-o[j].y)); sg.z = 1.0f / (1.0f + expf(-o[j].z)); sg.w = 1.0f / (1.0f + expf(-o[j].w));
            v[j] = sg * (v[j] * r * hg[j]); }
        st_row_bf16(Y + (size_t)m * D, lane, v);
    }
}
template <int MODE>
__device__ __forceinline__ void row_phase_C(Frame& F, const float* x_old, const float* post_g, const float* gate_base  ,
                                            const float* pre_g, const float* scsh_base  ) {
    if (MODE == 1) stage_gate_w(F, F.in[I_KV_W], KV_OUT, 2048, 16);
    const int gw = blockIdx.x * NWAVES + F.wave, m0 = gw * ROWS_PER_WAVE, b = m0 / SEQ, lane = F.lane;
    f32x4 gp[4];
    { f32x4 pg[4], gt[4]; ld_par(post_g, lane, pg); ld_par(gate_base + (size_t)b * 6144, lane, gt);
#pragma unroll
      for (int j = 0; j < 4; ++j) gp[j] = pg[j] * gt[j]; }
    f32x4 gs[4], sh[4], gs2[4], sh2[4];
    if (MODE != 2) { f32x4 g[4], sc[4]; ld_par(pre_g, lane, g); ld_par(scsh_base + (size_t)b * 6144 + 1024, lane, sc); ld_par(scsh_base + (size_t)b * 6144, lane, sh);
#pragma unroll
      for (int j = 0; j < 4; ++j) gs[j] = g[j] * (sc[j] + 1.0f); }
    if (MODE == 1) { const float* kvm = (const float*)(F.ws + WS_MOD) + (size_t)2 * 8 * 6144 + (size_t)b * 2048;
      f32x4 g[4], sc[4]; ld_par(F.in[I_KV_NORM_G], lane, g); ld_par(kvm + 1024, lane, sc); ld_par(kvm, lane, sh2);
#pragma unroll
      for (int j = 0; j < 4; ++j) gs2[j] = g[j] * (sc[j] + 1.0f); }
    const bf16* Z = (const bf16*)(F.ws + WS_RD); bf16* XN = (bf16*)(F.ws + WS_RA); bf16* XN2 = (bf16*)(F.ws + WS_RB);
    float* LOGF = (float*)(F.ws + WS_LOGF);
    const float fb = (MODE == 1) ? F.in[I_KV_FGATE_B][lane & 15] : 0.f;
    for (int i = 0; i < ROWS_PER_WAVE; ++i) {
        const int m = m0 + i, s = m - b * SEQ;
        f32x4 z[4], x[4]; ld_row_bf16(Z + (size_t)m * D, lane, z); ld_row_f32(x_old + (size_t)m * D, lane, x);
        const float rz = 1.0f / sqrtf(row_sumsq(z) * (1.0f / D) + EPS);
#pragma unroll
        for (int j = 0; j < 4; ++j) x[j] = x[j] + gp[j] * (z[j] * rz);
        st_row_f32(F.out + (size_t)m * D, lane, x);
        if (MODE != 2) {
            const float r = 1.0f / sqrtf(row_sumsq(x) * (1.0f / D) + EPS);
            f32x4 h[4];
#pragma unroll
            for (int j = 0; j < 4; ++j) h[j] = x[j] * r * gs[j] + sh[j];
            st_row_bf16(XN + (size_t)m * D, lane, h);
            if (MODE == 1) {
#pragma unroll
                for (int j = 0; j < 4; ++j) h[j] = x[j] * r * gs2[j] + sh2[j];
                st_row_bf16(XN2 + (size_t)m * D, lane, h);
                float mine = 0.f;
#pragma unroll 1
                for (int c = 0; c < 16; ++c) { const float t = wave_sum(gate_dot(F, h, c)); if (lane == c) mine = t; }
                if (lane < 16) LOGF[(size_t)(b * FH + lane) * SEQ + s] = logsigf(mine + fb);
            }
        }
    }
    if (MODE == 1) __syncthreads();
}
__device__ __forceinline__ void cumsum_f2(Frame& F) {
    const int gw = blockIdx.x * NWAVES + F.wave;
    if (gw >= BATCH * FH) return;
    const float* src = (const float*)(F.ws + WS_LOGF) + (size_t)gw * SEQ + 64 * F.lane; float* dst = (float*)(F.ws + WS_F2) + (size_t)gw * SEQ + 64 * F.lane;
    float tot = 0.f;
    for (int i = 0; i < 16; ++i) { const f32x4 v = *(const gf32x4*)(src + 4 * i); tot += (v.x + v.y) + (v.z + v.w); }
    float incl = tot;
#pragma unroll
    for (int o = 1; o < 64; o <<= 1) { const float t = __shfl_up(incl, o); if (F.lane >= o) incl += t; }
    float run = incl - tot;
    for (int i = 0; i < 16; ++i) { const f32x4 v = *(const gf32x4*)(src + 4 * i); f32x4 o;
        run += v.x; o.x = run * LOG2E; run += v.y; o.y = run * LOG2E; run += v.z; o.z = run * LOG2E; run += v.w; o.w = run * LOG2E;
        *(gf32x4*)(dst + 4 * i) = o; }
}

__device__ __forceinline__ void mlstm_naive(Frame& F) {
    LAS float* qs = (LAS float*)(F.lds);
    LAS float* ks = qs + 32 * 128;
    LAS float* vs = ks + 32 * 128;
    LAS float* nums = vs + 32 * 256;
    LAS float* gts = nums + 32 * 257;
    LAS float* ems = gts + 96;
    const bf16* PROJ = (const bf16*)(F.ws + WS_RP); bf16* HH = (bf16*)(F.ws + WS_RB);
    const float* IG = (const float*)(F.ws + WS_IG); const float* LFp = (const float*)(F.ws + WS_LF);
    const float qscale = 0.08838834764831845f;
    for (int bh = blockIdx.x; bh < BATCH * MH; bh += F.G) {
        const int b = bh / MH, h = bh % MH;
        float C[128];
#pragma unroll
        for (int k = 0; k < 128; ++k) C[k] = 0.f;
        float mrun = 0.f;
        for (int s0 = 0; s0 < SEQ; s0 += 32) {
            __syncthreads();
            for (int u = F.tid; u < 32 * 128; u += NWAVES * 64) { const int t = u >> 7, k = u & 127; const bf16* row = PROJ + (size_t)(b * SEQ + s0 + t) * M_INP;
                qs[u] = bf2f(row[h * MQK + k]) * qscale; ks[u] = bf2f(row[512 + h * MQK + k]); }
            for (int u = F.tid; u < 32 * 256; u += NWAVES * 64) { const int t = u >> 8, c = u & 255; vs[u] = bf2f(PROJ[(size_t)(b * SEQ + s0 + t) * M_INP + 1024 + h * MV + c]); }
            if (F.tid < 32) { gts[F.tid] = IG[(size_t)bh * SEQ + s0 + F.tid]; gts[32 + F.tid] = LFp[(size_t)bh * SEQ + s0 + F.tid]; }
            LDS_WAIT(); __syncthreads();
            if (F.tid <= 256) {
                for (int t = 0; t < 32; ++t) {
                    const float ig = gts[t], lf = gts[32 + t];
                    const float mn = fmaxf(lf + mrun, ig), fd = expf(lf + mrun - mn), ie = expf(ig - mn); mrun = mn;
                    const float sv = ie * (F.tid < 256 ? vs[t * 256 + F.tid] : 1.0f);
                    float num = 0.f;
                    const LAS f32x4* q4 = (const LAS f32x4*)(qs + t * 128); const LAS f32x4* k4 = (const LAS f32x4*)(ks + t * 128);
#pragma unroll
                    for (int k = 0; k < 32; ++k) { const f32x4 qq = q4[k], kk = k4[k];
                        C[4 * k + 0] = fd * C[4 * k + 0] + sv * kk.x; num += qq.x * C[4 * k + 0];
                        C[4 * k + 1] = fd * C[4 * k + 1] + sv * kk.y; num += qq.y * C[4 * k + 1];
                        C[4 * k + 2] = fd * C[4 * k + 2] + sv * kk.z; num += qq.z * C[4 * k + 2];
                        C[4 * k + 3] = fd * C[4 * k + 3] + sv * kk.w; num += qq.w * C[4 * k + 3]; }
                    nums[t * 257 + F.tid] = num;
                    if (F.tid == 256) ems[t] = expf(-mn);
                }
            }
            LDS_WAIT(); __syncthreads();
            for (int u = F.tid; u < 32 * 256; u += NWAVES * 64) { const int t = u >> 8, c = u & 255;
                const float den = fmaxf(fabsf(nums[t * 257 + 256]), ems[t]);
                HH[(size_t)(b * SEQ + s0 + t) * D + h * MV + c] = (bf16)f2bf(nums[t * 257 + c] / den); }
        }
        __syncthreads();
    }
}

__device__ __forceinline__ void attn_naive(Frame& F) {
    LAS float* Ks = (LAS float*)(F.lds);
    LAS float* Vs = Ks + 64 * 64;
    LAS float* Fs = Vs + 64 * 64;
    const bf16* Q = (const bf16*)(F.ws + WS_RP); const bf16* K = Q + (size_t)M * D; const bf16* V = K + (size_t)M * D; bf16* O = (bf16*)(F.ws + WS_RP);
    const float* F2 = (const float*)(F.ws + WS_F2);
    for (int u = blockIdx.x; u < BATCH * FH * (SEQ / 512); u += F.G) {
        const int bh = u / (SEQ / 512), qb = u % (SEQ / 512), b = bh / FH, h = bh % FH;
        const int t = qb * 512 + F.tid; const size_t rowq = (size_t)(b * SEQ + t) * D + h * FHD;
        float q[64], o[64];
#pragma unroll
        for (int d = 0; d < 64; ++d) { q[d] = bf2f(Q[rowq + d]); o[d] = 0.f; }
        const float ft = F2[(size_t)bh * SEQ + t];
        float mrun = -1e30f, l = 0.f;
        const int ntile = (qb * 512 + 512) / 64;
        for (int kt = 0; kt < ntile; ++kt) {
            __syncthreads();
            for (int e = F.tid; e < 64 * 64; e += NWAVES * 64) { const int j = e >> 6, d = e & 63; const size_t a = (size_t)(b * SEQ + kt * 64 + j) * D + h * FHD + d; Ks[e] = bf2f(K[a]); Vs[e] = bf2f(V[a]); }
            if (F.tid < 64) Fs[F.tid] = F2[(size_t)bh * SEQ + kt * 64 + F.tid];
            LDS_WAIT(); __syncthreads();
            for (int j = 0; j < 64; ++j) {
                if (kt * 64 + j <= t) {
                    float x = 0.f; const LAS f32x4* k4 = (const LAS f32x4*)(Ks + j * 64);
#pragma unroll
                    for (int d = 0; d < 16; ++d) { const f32x4 kk = k4[d]; x += q[4 * d] * kk.x + q[4 * d + 1] * kk.y + q[4 * d + 2] * kk.z + q[4 * d + 3] * kk.w; }
                    x += ft - Fs[j];
                    const float mn = fmaxf(mrun, x), al = exp2f(mrun - mn), p = exp2f(x - mn); mrun = mn; l = l * al + p;
                    const LAS f32x4* v4 = (const LAS f32x4*)(Vs + j * 64);
#pragma unroll
                    for (int d = 0; d < 16; ++d) { const f32x4 vv = v4[d]; o[4 * d] = o[4 * d] * al + p * vv.x; o[4 * d + 1] = o[4 * d + 1] * al + p * vv.y; o[4 * d + 2] = o[4 * d + 2] * al + p * vv.z; o[4 * d + 3] = o[4 * d + 3] * al + p * vv.w; }
                }
            }
        }
        const float rl = 1.0f / l;
#pragma unroll
        for (int d = 0; d < 64; ++d) O[rowq + d] = (bf16)f2bf(o[d] * rl);
        __syncthreads();
    }
}

constexpr int NPHASES = 17;
struct Args { const float* in[21]; float* out; unsigned char* ws; int ph_lo, ph_hi, use_bar, pad; };
__global__ void __launch_bounds__(NWAVES * 64, 2) yoco_fwd(Args args) {
    extern __shared__ __attribute__((aligned(16))) unsigned char lds[];
    Frame F;
    F.lds = (LAS unsigned char*)lds;
    F.MISC = (volatile LAS unsigned*)(F.lds + MISC_OFF);
    F.tid = threadIdx.x; F.lane = F.tid & 63; F.wave = __builtin_amdgcn_readfirstlane(F.tid >> 6);
    F.G = gridDim.x;
    F.ws = args.ws; F.out = args.out; F.ctl = (gu32*)(args.ws + WS_CTL);
    F.in = args.in;
    for (int u = F.tid; u < (LDS_BYTES - LDSCTL_OFF) / 4; u += NWAVES * 64) ((LAS unsigned*)(F.lds + LDSCTL_OFF))[u] = 0u;
    __syncthreads();
    XcdBarrier bar; bar.bar = (unsigned*)(F.ctl + CW_BAR); bar.x = 0; bar.st = nullptr;
    if (args.use_bar) bar = xcd_barrier_post((unsigned*)(F.ctl + CW_BAR), F.MISC + 8);

    const int lo = args.ph_lo, hi = args.ph_hi;
#define IN(k) (lo <= (k) && (k) < hi)
#define SEAM(k) do { if (IN(k) && (k) > lo) xcd_barrier(bar); } while (0)
#define WSP(off) (args.ws + (off))
#define MODP ((const float*)(args.ws + WS_MOD))
#define GEMM_BF16(Aoff, Boff, N_, K_, Ooff, ldc_, split_, stride_, scale_) do { \
        pg8::Gemm g{(const pg8::bf16_t*)WSP(Aoff), (const pg8::bf16_t*)WSP(Boff), M, (N_), (K_)}; pg8::StaticOrder S; S.init(M, (N_), F.G, (int)blockIdx.x); \
        pg8::EpiBf16 E{(pg8::bf16_t*)WSP(Ooff), (ldc_), (split_), (size_t)(stride_), (scale_)}; \
        pg8::gemm_phase<pg8::EpiBf16, pg8::StaticOrder, true, true>(F.lds + RING_OFF, g, S, E); } while (0)
#define GEMM_SWIGLU(Aoff, Boff, Ooff) do { \
        pg8::Gemm g{(const pg8::bf16_t*)WSP(Aoff), (const pg8::bf16_t*)WSP(Boff), M, 2 * DFF, D}; pg8::StaticOrder S; S.init(M, 2 * DFF, F.G, (int)blockIdx.x); \
        pg8::EpiSwiGLU E{(pg8::bf16_t*)WSP(Ooff), DFF}; \
        pg8::gemm_phase<pg8::EpiSwiGLU, pg8::StaticOrder, true, true>(F.lds + RING_OFF, g, S, E); } while (0)

    SEAM(0);  if (IN(0)) p0_prologue(F);
    SEAM(1);  if (IN(1)) row_phase_A(F);
    SEAM(2);  if (IN(2)) GEMM_BF16(WS_RA, WS_WA_IN, M_INP, D, WS_RP, M_INP, 0, 0, 1.f);
    SEAM(3);  if (IN(3)) mlstm_naive(F);
    SEAM(4);  if (IN(4)) row_phase_B(F);
    SEAM(5);  if (IN(5)) GEMM_BF16(WS_RA, WS_WA_OUT, D, D, WS_RD, D, 0, 0, 1.f);
    SEAM(6);  if (IN(6)) row_phase_C<0>(F, args.in[I_X], args.in[I_MIX_POST_G], MODP + 2048, args.in[I_FFN_PRE_G], MODP + 3072);
    SEAM(7);  if (IN(7)) GEMM_SWIGLU(WS_RA, WS_WFI, WS_RP);
    SEAM(8);  if (IN(8)) GEMM_BF16(WS_RP, WS_WFO, D, DFF, WS_RD, D, 0, 0, 1.f);
    SEAM(9);  if (IN(9)) row_phase_C<1>(F, args.out, args.in[I_FFN_POST_G], MODP + 5120, args.in[I_MIX_PRE_G] + 1024, MODP + (size_t)8 * 6144);
    SEAM(10); if (IN(10)) { cumsum_f2(F);
                            GEMM_BF16(WS_RB, WS_WKV, 2048, D, WS_RP + 64 * MiB, D, 1024, (size_t)M * D, 1.f);
                            GEMM_BF16(WS_RA, WS_WQ, D, D, WS_RP, D, 1024, 0, QSCALE2); }
    SEAM(11); if (IN(11)) attn_naive(F);
    SEAM(12); if (IN(12)) GEMM_BF16(WS_RP, WS_WBO, D, D, WS_RD, D, 0, 0, 1.f);
    SEAM(13); if (IN(13)) row_phase_C<0>(F, args.out, args.in[I_MIX_POST_G] + 1024, MODP + (size_t)8 * 6144 + 2048, args.in[I_FFN_PRE_G] + 1024, MODP + (size_t)8 * 6144 + 3072);
    SEAM(14); if (IN(14)) GEMM_SWIGLU(WS_RA, WS_WFI + WFI_STRIDE, WS_RP);
    SEAM(15); if (IN(15)) GEMM_BF16(WS_RP, WS_WFO + WFO_STRIDE, D, DFF, WS_RD, D, 0, 0, 1.f);
    SEAM(16); if (IN(16)) row_phase_C<2>(F, args.out, args.in[I_FFN_POST_G] + 1024, MODP + (size_t)8 * 6144 + 5120, nullptr, nullptr);
}

#ifndef MK_PER_PHASE
#define MK_PER_PHASE 0
#endif
extern "C" void kernel_launch(void* const* d_in, const int* in_sizes, int n_in, void* d_out, int out_size, void* d_ws, size_t ws_size, hipStream_t stream) {
    static int grid = 0;
    if (grid == 0) {
        if (n_in != 21 || in_sizes[0] != M * D || out_size != M * D || ws_size < WS_END) { fprintf(stderr, "kernel_launch: unexpected shapes: n_in %d in0 %d out %d ws %zu (need %zu)\n", n_in, n_in > 0 ? in_sizes[0] : -1, out_size, ws_size, (size_t)WS_END); grid = -1; return; }
        int dev = 0, cus = 0, per_cu = 0;
        if (hipGetDevice(&dev) != hipSuccess || hipDeviceGetAttribute(&cus, hipDeviceAttributeMultiprocessorCount, dev) != hipSuccess) { grid = -1; return; }
        if (hipFuncSetAttribute((const void*)yoco_fwd, hipFuncAttributeMaxDynamicSharedMemorySize, LDS_BYTES) != hipSuccess) { fprintf(stderr, "kernel_launch: hipFuncSetAttribute failed\n"); grid = -1; return; }
        if (hipOccupancyMaxActiveBlocksPerMultiprocessor(&per_cu, (const void*)yoco_fwd, NWAVES * 64, LDS_BYTES) != hipSuccess || per_cu < 1)
            fprintf(stderr, "kernel_launch: note: occupancy query reports %d workgroups per CU\n", per_cu);
        (void)hipGetLastError();
        grid = cus;
        if (grid != 256) { fprintf(stderr, "kernel_launch: built for 256 CUs, device has %d\n", grid); }
    }
    if (grid < 0) return;
    if (hipMemsetAsync((char*)d_ws + WS_CTL, 0, CTL_ZERO_BYTES, stream) != hipSuccess) { fprintf(stderr, "kernel_launch: hipMemsetAsync failed\n"); return; }
    Args a{};
    for (int i = 0; i < 21; ++i) a.in[i] = (const float*)d_in[i];
    a.out = (float*)d_out; a.ws = (unsigned char*)d_ws;
#if MK_PER_PHASE
    for (int ph = 0; ph < NPHASES; ++ph) {
        a.ph_lo = ph; a.ph_hi = ph + 1; a.use_bar = 0;
        hipLaunchKernelGGL(yoco_fwd, dim3(256), dim3(NWAVES * 64), LDS_BYTES, stream, a);
    }
#else
    a.ph_lo = 0; a.ph_hi = NPHASES; a.use_bar = 1;
    hipLaunchKernelGGL(yoco_fwd, dim3(256), dim3(NWAVES * 64), LDS_BYTES, stream, a);
#endif
    const hipError_t le = hipPeekAtLastError();
    if (le != hipSuccess) fprintf(stderr, "kernel_launch: launch failed: %s\n", hipGetErrorName(le));
}
```

```cpp
#include <hip/hip_runtime.h>
#include <hip/hip_bf16.h>
#include <cstdio>
#include <cstdint>
#include <cmath>
namespace pg8 {
#define PG8_LAS __attribute__((address_space(3)))
typedef unsigned short bf16_t;
typedef short bf16x8 __attribute__((ext_vector_type(8)));
typedef float f32x4 __attribute__((ext_vector_type(4)));
typedef unsigned u32x4 __attribute__((ext_vector_type(4)));
constexpr int BM = 256, BK = 64, HALF = 128, HTB = HALF * BK * 2  , STAGE_BYTES = 8 * HTB, NXCD = 8, WGM = 8;

__host__ __device__ __forceinline__ int lds_byte(int r, int c) { const int st = (r >> 4) * 2 + (c >> 5), rr = r & 15, cc = c & 31, ob = rr * 64 + cc * 2; return st * 1024 + (ob ^ (((ob >> 9) & 1) << 5)); }
__host__ __device__ __forceinline__ void stage_rc(int b, int& R, int& C) { const int st = b / 1024, sb = b % 1024, swz = sb ^ (((sb >> 9) & 1) << 5); R = (st >> 1) * 16 + swz / 64; C = (st & 1) * 32 + (swz % 64) / 2; }
__host__ __device__ __forceinline__ int perm32(int rho) { const int n = rho >> 4, i = rho & 15; return 8 * (i >> 2) + 4 * n + (i & 3); }

struct Unit { int pm, pn; };
struct Gemm { const bf16_t* A; const bf16_t* Bt; int M, N, K; };

struct StaticOrder {
    int nM, nN, nwg, G, c;
    __host__ __device__ void init(int M, int N, int G_, int c_) { nM = M / BM; nN = N / BM; nwg = nM * nN; G = G_; c = c_; }
    __host__ __device__ bool next(int i, Unit& u) const {
        const long L = (long)i * G + c; if (L >= nwg) return false;
        int wgid = (int)L; { const int q = nwg / NXCD, r = nwg % NXCD, xcd = wgid % NXCD, off = wgid / NXCD; wgid = (xcd < r ? xcd * (q + 1) : r * (q + 1) + (xcd - r) * q) + off; }
        const int nig = WGM * nN, gid = wgid / nig, fm = gid * WGM, gsz = (nM - fm) < WGM ? (nM - fm) : WGM;
        u.pm = fm + ((wgid % nig) % gsz); u.pn = (wgid % nig) / gsz; return true;
    }
    __device__ __forceinline__ void a_ready(const Unit&) const {}
    __device__ __forceinline__ void done(const Unit&) const {}
};

__device__ __forceinline__ unsigned cvt_pk_bf16(float lo, float hi) { unsigned r; asm volatile("v_cvt_pk_bf16_f32 %0, %1, %2" : "=v"(r) : "v"(lo), "v"(hi)); return r; }
struct EpiBf16 {
    static constexpr bool PERM = true, AFTER_DRAIN = false;
    bf16_t* O; int ldc; int split_cols; size_t split_stride; float scale0;
    __device__ __forceinline__ void operator()(const f32x4 (&acc)[2][2][4][2], const Unit& u, int wr, int wc, int fr, int fq) const {
        const int row0 = u.pm * BM + wr * 64 + fr; int colt = u.pn * BM; bf16_t* base = O;
        float sc = 1.f; if (split_cols) { const int t = colt / split_cols; base += (size_t)t * split_stride; colt -= t * split_cols; if (t == 0) sc = scale0; }
        const int col0 = colt + wc * 32 + 8 * fq;
#pragma unroll
        for (int ai = 0; ai < 2; ++ai)
#pragma unroll
            for (int m = 0; m < 4; ++m) { bf16_t* rowp = base + (size_t)(row0 + ai * HALF + m * 16) * ldc + col0;
#pragma unroll
                for (int bj = 0; bj < 2; ++bj) { f32x4 v0 = acc[ai][bj][m][0], v1 = acc[ai][bj][m][1];
                    v0 = v0 * sc; v1 = v1 * sc; u32x4 w; w.x = cvt_pk_bf16(v0[0], v0[1]); w.y = cvt_pk_bf16(v0[2], v0[3]); w.z = cvt_pk_bf16(v1[0], v1[1]); w.w = cvt_pk_bf16(v1[2], v1[3]);
                    *(u32x4*)(rowp + bj * HALF) = w; } }
    }
};
__device__ __forceinline__ float silu_mul(float g, float u) { return g * u * __builtin_amdgcn_rcpf(1.0f + __builtin_amdgcn_exp2f(-1.4426950408889634f * g)); }
struct EpiSwiGLU {
    static constexpr bool PERM = true, AFTER_DRAIN = false;
    bf16_t* O; int ldc;
    __device__ __forceinline__ void operator()(const f32x4 (&acc)[2][2][4][2], const Unit& u, int wr, int wc, int fr, int fq) const {
        const int row0 = u.pm * BM + wr * 64 + fr; const int col0 = u.pn * HALF + wc * 32 + 8 * fq;
#pragma unroll
        for (int ai = 0; ai < 2; ++ai)
#pragma unroll
            for (int m = 0; m < 4; ++m) { bf16_t* rowp = O + (size_t)(row0 + ai * HALF + m * 16) * ldc + col0;
                const f32x4 g0 = acc[ai][0][m][0], g1 = acc[ai][0][m][1], u0 = acc[ai][1][m][0], u1 = acc[ai][1][m][1];
                u32x4 w; w.x = cvt_pk_bf16(silu_mul(g0[0], u0[0]), silu_mul(g0[1], u0[1])); w.y = cvt_pk_bf16(silu_mul(g0[2], u0[2]), silu_mul(g0[3], u0[3]));
                w.z = cvt_pk_bf16(silu_mul(g1[0], u1[0]), silu_mul(g1[1], u1[1])); w.w = cvt_pk_bf16(silu_mul(g1[2], u1[2]), silu_mul(g1[3], u1[3]));
                *(u32x4*)rowp = w; }
    }
};

template <class Epi, class Sched, bool ALIGN_EPI = false, bool SP2 = false>
__device__ __forceinline__ void gemm_phase(PG8_LAS unsigned char* lds, const Gemm g, const Sched& S, const Epi& E) {
    const int tid = threadIdx.x, wid = __builtin_amdgcn_readfirstlane(tid >> 6), lane = tid & 63, wr = wid >> 2, wc = wid & 3, fr = lane & 15, fq = lane >> 4;
    const int K = g.K, nt = K / BK;
    unsigned voffA[2], voffB[2];
#pragma unroll
    for (int i = 0; i < 2; ++i) { int R, C; stage_rc(tid * 16 + i * 8192, R, C); const int Rb = Epi::PERM ? ((R & ~31) + perm32(R & 31)) : R;
        voffA[i] = (unsigned)(R * K + C) * 2u; voffB[i] = (unsigned)(Rb * K + C) * 2u; }
    const size_t kstep = (size_t)(BK * 2);
    const size_t hstep = (size_t)HALF * K * 2;
    const size_t tstep = 2 * hstep;
    const unsigned ldsw = (unsigned)wid * 1024u;
    const int aoff = lds_byte(wr * 64 + fr, fq * 8), boff = lds_byte(wc * 32 + fr, fq * 8);
#define PG8_SA(b, h) (((b) * 2 + (h)) * HTB)
#define PG8_SB(b, h) ((4 + (b) * 2 + (h)) * HTB)
#define PG8_STAGE(bufoff, gbase, voff) do { _Pragma("unroll") for (int _i = 0; _i < 2; ++_i) \
        __builtin_amdgcn_global_load_lds((const unsigned*)((const char*)(gbase) + (voff)[_i]), (PG8_LAS unsigned*)(lds + (bufoff) + ldsw + _i * 8192), 16, 0, 0); } while (0)
#define PG8_LDA(dst, b, h) do { _Pragma("unroll") for (int m = 0; m < 4; ++m) _Pragma("unroll") for (int k = 0; k < 2; ++k) dst[m][k] = *(const PG8_LAS bf16x8*)(lds + PG8_SA(b, h) + aoff + m * 2048 + k * 1024); } while (0)
#define PG8_LDB(dst, b, h) do { _Pragma("unroll") for (int n = 0; n < 2; ++n) _Pragma("unroll") for (int k = 0; k < 2; ++k) dst[n][k] = *(const PG8_LAS bf16x8*)(lds + PG8_SB(b, h) + boff + n * 2048 + k * 1024); } while (0)
#define PG8_MMA(ai, bj, At, Bt) do { __builtin_amdgcn_s_setprio(1); _Pragma("unroll") for (int m = 0; m < 4; ++m) _Pragma("unroll") for (int n = 0; n < 2; ++n) _Pragma("unroll") for (int k = 0; k < 2; ++k) \
        acc[ai][bj][m][n] = __builtin_amdgcn_mfma_f32_16x16x32_bf16(Bt[n][k], At[m][k], acc[ai][bj][m][n], 0, 0, 0); __builtin_amdgcn_s_setprio(0); } while (0)
#define PG8_WAIT_V(n) asm volatile("s_waitcnt vmcnt(" #n ")" ::: "memory")
#define PG8_WAIT_L(n) asm volatile("s_waitcnt lgkmcnt(" #n ")" ::: "memory")
#define PG8_BAR __builtin_amdgcn_s_barrier()
#define PG8_SCHED __builtin_amdgcn_sched_barrier(0)
    Unit cur, nxt; int ui = 0;
    if (!S.next(0, cur)) return;
    f32x4 acc[2][2][4][2];
#pragma unroll
    for (int a = 0; a < 2; ++a)
#pragma unroll
        for (int b = 0; b < 2; ++b)
#pragma unroll
            for (int m = 0; m < 4; ++m)
#pragma unroll
                for (int n = 0; n < 2; ++n) acc[a][b][m][n] = (f32x4){0.f, 0.f, 0.f, 0.f};
    bf16x8 At[4][2], B0[2][2], B1[2][2];
    const char* cA = (const char*)g.A + (size_t)cur.pm * tstep; const char* cB = (const char*)g.Bt + (size_t)cur.pn * tstep;
    S.a_ready(cur);
    if constexpr (SP2) {
        PG8_STAGE(PG8_SB(0, 0), cB, voffB); PG8_STAGE(PG8_SB(0, 1), cB + hstep, voffB); PG8_STAGE(PG8_SA(0, 0), cA, voffA); PG8_STAGE(PG8_SA(0, 1), cA + hstep, voffA);
        if (wr == 1) PG8_BAR;
        PG8_WAIT_V(2); PG8_BAR;
        PG8_STAGE(PG8_SB(1, 0), cB + kstep, voffB); PG8_STAGE(PG8_SA(1, 0), cA + kstep, voffA); PG8_STAGE(PG8_SB(1, 1), cB + hstep + kstep, voffB);
        PG8_WAIT_V(6); PG8_BAR;
    } else {
        PG8_STAGE(PG8_SB(0, 0), cB, voffB); PG8_STAGE(PG8_SA(0, 0), cA, voffA); PG8_STAGE(PG8_SB(0, 1), cB + hstep, voffB); PG8_STAGE(PG8_SA(0, 1), cA + hstep, voffA);
        if (wr == 1) PG8_BAR;
        PG8_WAIT_V(4); PG8_BAR;
        PG8_STAGE(PG8_SB(1, 0), cB + kstep, voffB); PG8_STAGE(PG8_SA(1, 0), cA + kstep, voffA); PG8_STAGE(PG8_SB(1, 1), cB + hstep + kstep, voffB);
        PG8_WAIT_V(6); PG8_BAR;
    }
    for (;;) {
        const bool has_next = S.next(ui + 1, nxt);
        const char* nA = has_next ? (const char*)g.A + (size_t)nxt.pm * tstep : cA; const char* nB = has_next ? (const char*)g.Bt + (size_t)nxt.pn * tstep : cB;
        for (int t = 0; t < nt; t += 2) {
            const bool last = (t == nt - 2);
            const char* a1 = cA + (size_t)(t + 1) * kstep;
            const char* a2 = last ? nA : cA + (size_t)(t + 2) * kstep; const char* b2 = last ? nB : cB + (size_t)(t + 2) * kstep;
            const char* a3 = a2 + kstep; const char* b3 = b2 + kstep;
            if (last && has_next) S.a_ready(nxt);
            if constexpr (SP2) {
            PG8_LDB(B0, 0, 0); PG8_LDB(B1, 0, 1); PG8_SCHED; PG8_LDA(At, 0, 0); PG8_STAGE(PG8_SA(1, 1), a1 + hstep, voffA);
            PG8_WAIT_V(8); PG8_WAIT_L(0); PG8_BAR; PG8_MMA(0, 0, At, B0); PG8_MMA(0, 1, At, B1); PG8_BAR; PG8_SCHED;
            PG8_LDA(At, 0, 1); PG8_STAGE(PG8_SB(0, 0), b2, voffB); PG8_STAGE(PG8_SB(0, 1), b2 + hstep, voffB); PG8_STAGE(PG8_SA(0, 0), a2, voffA);
            PG8_WAIT_V(8); PG8_WAIT_L(0); PG8_BAR; PG8_MMA(1, 0, At, B0); PG8_MMA(1, 1, At, B1); PG8_BAR; PG8_SCHED;
            PG8_LDB(B0, 1, 0); PG8_LDB(B1, 1, 1); PG8_SCHED; PG8_LDA(At, 1, 0); PG8_STAGE(PG8_SA(0, 1), a2 + hstep, voffA);
            PG8_WAIT_V(8); PG8_WAIT_L(0); PG8_BAR; PG8_MMA(0, 0, At, B0); PG8_MMA(0, 1, At, B1); PG8_BAR; PG8_SCHED;
            PG8_LDA(At, 1, 1); PG8_STAGE(PG8_SB(1, 0), b3, voffB); PG8_STAGE(PG8_SB(1, 1), b3 + hstep, voffB); PG8_STAGE(PG8_SA(1, 0), a3, voffA);
            PG8_WAIT_V(8); PG8_WAIT_L(0); PG8_BAR; PG8_MMA(1, 0, At, B0); PG8_MMA(1, 1, At, B1); PG8_BAR; PG8_SCHED;
            } else {
            PG8_LDB(B0, 0, 0); PG8_SCHED; PG8_LDA(At, 0, 0); PG8_STAGE(PG8_SA(1, 1), a1 + hstep, voffA);
            PG8_WAIT_L(8); PG8_BAR; PG8_WAIT_L(0); PG8_MMA(0, 0, At, B0); PG8_BAR; PG8_SCHED;
            PG8_LDB(B1, 0, 1); PG8_STAGE(PG8_SB(0, 0), b2, voffB);
            PG8_BAR; PG8_WAIT_L(0); PG8_MMA(0, 1, At, B1); PG8_BAR;
            PG8_LDA(At, 0, 1); PG8_STAGE(PG8_SA(0, 0), a2, voffA);
            PG8_BAR; PG8_WAIT_L(0); PG8_MMA(1, 0, At, B0); PG8_BAR; PG8_SCHED;
            PG8_STAGE(PG8_SB(0, 1), b2 + hstep, voffB);
            PG8_WAIT_V(6); PG8_BAR; PG8_MMA(1, 1, At, B1); PG8_BAR;
            PG8_LDB(B0, 1, 0); PG8_SCHED; PG8_LDA(At, 1, 0); PG8_STAGE(PG8_SA(0, 1), a2 + hstep, voffA);
            PG8_WAIT_L(8); PG8_BAR; PG8_WAIT_L(0); PG8_MMA(0, 0, At, B0); PG8_BAR; PG8_SCHED;
            PG8_LDB(B1, 1, 1); PG8_STAGE(PG8_SB(1, 0), b3, voffB);
            PG8_BAR; PG8_WAIT_L(0); PG8_MMA(0, 1, At, B1); PG8_BAR;
            PG8_LDA(At, 1, 1); PG8_STAGE(PG8_SA(1, 0), a3, voffA);
            PG8_BAR; PG8_WAIT_L(0); PG8_MMA(1, 0, At, B0); PG8_BAR; PG8_SCHED;
            PG8_STAGE(PG8_SB(1, 1), b3 + hstep, voffB);
            PG8_WAIT_V(6); PG8_BAR; PG8_MMA(1, 1, At, B1); PG8_BAR;
            }
        }
        if constexpr (ALIGN_EPI) { if (wr == 0) PG8_BAR; }
        if constexpr (!Epi::AFTER_DRAIN) { E(acc, cur, wr, wc, fr, fq); S.done(cur); }
        if (!has_next) break;
#pragma unroll
        for (int a = 0; a < 2; ++a)
#pragma unroll
            for (int b = 0; b < 2; ++b)
#pragma unroll
                for (int m = 0; m < 4; ++m)
#pragma unroll
                    for (int n = 0; n < 2; ++n) acc[a][b][m][n] = (f32x4){0.f, 0.f, 0.f, 0.f};
        cur = nxt; cA = nA; cB = nB; ++ui;
        if constexpr (ALIGN_EPI) { if (wr == 1) PG8_BAR; }
    }
    PG8_WAIT_V(0);
    if constexpr (!ALIGN_EPI) { if (wr == 0) PG8_BAR; }
    PG8_BAR;
    if constexpr (Epi::AFTER_DRAIN) { E.fused(acc, cur, wr, wc, fr, fq, lds, wid, lane); S.done(cur); }
#undef PG8_SA
#undef PG8_SB
#undef PG8_STAGE
#undef PG8_LDA
#undef PG8_LDB
#undef PG8_MMA
#undef PG8_WAIT_V
#undef PG8_WAIT_L
#undef PG8_BAR
#undef PG8_SCHED
}
}
#define GAS __attribute__((address_space(1)))
#define LAS __attribute__((address_space(3)))
typedef unsigned short bf16;
typedef unsigned v4u __attribute__((ext_vector_type(4)));
typedef float f32x4 __attribute__((ext_vector_type(4)));
typedef short bf16x8 __attribute__((ext_vector_type(8)));
typedef GAS unsigned gu32;
typedef GAS unsigned long long gu64;
#define RLX_AGENT __ATOMIC_RELAXED, __HIP_MEMORY_SCOPE_AGENT
#define LDS_WAIT() asm volatile("s_waitcnt lgkmcnt(0)" ::: "memory")
#define VM_WAIT() asm volatile("s_waitcnt vmcnt(0)" ::: "memory")
__device__ __forceinline__ unsigned long long rt() { return __builtin_amdgcn_s_memrealtime(); }
__device__ __forceinline__ unsigned f2bf(float f) { unsigned u = __builtin_bit_cast(unsigned, f); return (u + 0x7fffu + ((u >> 16) & 1u)) >> 16; }
__device__ __forceinline__ unsigned pk2(float lo, float hi) { return f2bf(lo) | (f2bf(hi) << 16); }

#define XB_TMO      128
#define XB_XCNT(j)  (256  + 64 * (j))
#define XB_XSUB(j)  (1280 + 64 * (j))
#define XB_XGEN(j)  (2304 + 64 * (j))
#define XB_TOP      3328
#define XB_TOPGEN   3392
#define XCD_BAR_WORDS 3456
#define XB_SPIN_CAP (1u << 18)

__device__ __forceinline__ unsigned xb_ld(unsigned* p)              { return __hip_atomic_load(p, __ATOMIC_RELAXED, __HIP_MEMORY_SCOPE_AGENT); }
__device__ __forceinline__ unsigned xb_add(unsigned* p, unsigned v) { return __hip_atomic_fetch_add(p, v, __ATOMIC_RELAXED, __HIP_MEMORY_SCOPE_AGENT); }
__device__ __forceinline__ unsigned xb_xcc_id() { return (unsigned)__builtin_amdgcn_s_getreg((3 << 11) | 20) & 0xFu; }
#define XB_SPIN(cond, bar) do { unsigned _sp = 0; while (cond) { __builtin_amdgcn_s_sleep(1); \
    if ((++_sp & 255u) == 0u) { if (xb_ld(&(bar)[XB_TMO])) break; if (_sp > XB_SPIN_CAP) { atomicAdd(&(bar)[XB_TMO], 1u); break; } } } } while (0)

struct XcdBarrier {
    unsigned* bar; unsigned x;
    volatile LAS unsigned* st;
};

__device__ __forceinline__ XcdBarrier xcd_barrier_post(unsigned* bar, volatile LAS unsigned* st) {
    XcdBarrier b; b.bar = bar; b.x = xb_xcc_id(); b.st = st;
    if (threadIdx.x == 0) (void)xb_add(&bar[XB_XCNT(b.x)], 1u);
    return b;
}
__device__ __forceinline__ void xcd_barrier_complete(unsigned* bar, unsigned x, unsigned& nloc, unsigned& nx) {
    const unsigned G = gridDim.x * gridDim.y * gridDim.z;
    unsigned sum, cnt, mine, sp = 0u;
    for (;;) {
        sum = 0u; cnt = 0u; mine = 0u;
#pragma unroll
        for (unsigned j = 0; j < 16; ++j) { const unsigned c = xb_ld(&bar[XB_XCNT(j)]); sum += c; cnt += (c > 0u) ? 1u : 0u; mine = (j == x) ? c : mine; }
        if (sum == G) break;
        __builtin_amdgcn_s_sleep(1);
        if ((++sp & 255u) == 0u) { if (xb_ld(&bar[XB_TMO])) break; if (sp > XB_SPIN_CAP) { atomicAdd(&bar[XB_TMO], 1u); break; } }
    }
    nloc = mine > 0u ? mine : 1u; nx = cnt > 0u ? cnt : 1u;
}

__device__ __forceinline__ void xcd_barrier(const XcdBarrier& b) {
    asm volatile("s_waitcnt vmcnt(0)" ::: "memory");
    __syncthreads();
    if (threadIdx.x == 0) {
        unsigned* bar = b.bar;
        __builtin_amdgcn_s_waitcnt(0);
        unsigned nloc = b.st[0], nx = b.st[1];
        if (nloc == 0u) { xcd_barrier_complete(bar, b.x, nloc, nx); b.st[0] = nloc; b.st[1] = nx; }
        const unsigned old = xb_add(&bar[XB_XSUB(b.x)], 1u);
        const unsigned gen = old / nloc;
        if (old + 1u == (gen + 1u) * nloc) {
            __builtin_amdgcn_fence(__ATOMIC_RELEASE, "agent");
            asm volatile("s_waitcnt vmcnt(0)" ::: "memory");
            const unsigned og = xb_add(&bar[XB_TOP], 1u);
            const unsigned tg = og / nx;
            if (og + 1u == (tg + 1u) * nx) xb_add(&bar[XB_TOPGEN], 1u);
            else XB_SPIN(xb_ld(&bar[XB_TOPGEN]) == tg, bar);
            __builtin_amdgcn_fence(__ATOMIC_ACQUIRE, "agent");
            xb_add(&bar[XB_XGEN(b.x)], 1u);
            asm volatile("s_waitcnt vmcnt(0)" ::: "memory");
        } else {
            XB_SPIN(xb_ld(&bar[XB_XGEN(b.x)]) == gen, bar);
            __builtin_amdgcn_fence(__ATOMIC_ACQUIRE, "agent");
            asm volatile("s_waitcnt vmcnt(0)" ::: "memory");
        }
    }
    __syncthreads();
}
constexpr int NWAVES = 8;
constexpr int BATCH = 8, SEQ = 4096, D = 1024, M = BATCH * SEQ;
constexpr int MH = 4, MQK = 128, MV = 256, M_IN = 3080, M_INP = 3072;
constexpr int FH = 16, FHD = 64, KV_OUT = 2064;
constexpr int DFF = 2816;
constexpr float EPS = 1e-6f, GATE_CAP = 15.0f;
constexpr float LOG2E = 1.4426950408889634f;
constexpr float QSCALE2 = 0.125f * LOG2E;

constexpr size_t MiB = 1u << 20;
constexpr size_t WS_CTL = 0, CTL_ZERO_BYTES = 1 * MiB;
constexpr size_t WS_MOD = 1 * MiB;
constexpr size_t WS_IG = 2 * MiB, WS_LF = 2 * MiB + 512 * 1024;
constexpr size_t WS_LOGF = 3 * MiB, WS_F2 = 5 * MiB;
constexpr size_t WS_WA_IN = 8 * MiB, WS_WA_OUT = 14 * MiB, WS_WKV = 16 * MiB, WS_WQ = 20 * MiB, WS_WBO = 22 * MiB;
constexpr size_t WS_WFI = 24 * MiB, WFI_STRIDE = 11 * MiB;
constexpr size_t WS_WFO = 46 * MiB, WFO_STRIDE = 5632 * 1024;
constexpr size_t WS_RA = 64 * MiB, WS_RB = 128 * MiB, WS_RD = 192 * MiB, WS_RP = 256 * MiB, WS_END = 448 * MiB;
constexpr int CW_BAR = 4096, CW_NORM = 8192;

constexpr int RING_OFF = 0, RING_BYTES = 131072;
constexpr int LDSCTL_OFF = RING_BYTES, MISC_OFF = LDSCTL_OFF + 320;
constexpr int LDS_BYTES = 147456;

typedef GAS f32x4 gf32x4;
typedef unsigned u32x2 __attribute__((ext_vector_type(2)));
__device__ __forceinline__ float bf2f(unsigned short h) { return __builtin_bit_cast(float, (unsigned)h << 16); }
__device__ __forceinline__ float bflo(unsigned w) { return __builtin_bit_cast(float, w << 16); }
__device__ __forceinline__ float bfhi(unsigned w) { return __builtin_bit_cast(float, w & 0xffff0000u); }

struct Frame {
    LAS unsigned char* lds;
    volatile LAS unsigned* MISC;
    gu32* ctl;
    int tid, lane, wave, G;
    const float* const* in; float* out; unsigned char* ws;
};
enum { I_X = 0, I_C, I_MOD_W, I_MOD_B, I_MIX_PRE_G, I_MIX_POST_G, I_FFN_PRE_G, I_FFN_POST_G, I_FFN_W_IN, I_FFN_W_OUT, I_A_W_IN, I_A_GATE_B, I_A_HNORM_G, I_A_W_OUT,
       I_KV_NORM_G, I_KV_MOD_W, I_KV_MOD_B, I_KV_W, I_KV_FGATE_B, I_B_W_Q, I_B_W_OUT };

__device__ __forceinline__ float wave_sum(float v) {
#pragma unroll
    for (int o = 1; o < 64; o <<= 1) v += __shfl_xor(v, o);
    return v;
}
__device__ __forceinline__ float dot4(f32x4 a, f32x4 b) { return (a.x * b.x + a.y * b.y) + (a.z * b.z + a.w * b.w); }
__device__ __forceinline__ float softcapf(float a) { return GATE_CAP * tanhf(a * (1.0f / GATE_CAP)); }
__device__ __forceinline__ float logsigf(float x) { return fminf(x, 0.f) - log1pf(expf(-fabsf(x))); }

__device__ __forceinline__ void ld_row_f32(const float* p, int lane, f32x4 (&v)[4]) {
    const gf32x4* xr = (const gf32x4*)p + lane;
#pragma unroll
    for (int j = 0; j < 4; ++j) v[j] = xr[64 * j];
}
__device__ __forceinline__ void st_row_f32(float* p, int lane, const f32x4 (&v)[4]) {
    gf32x4* xr = (gf32x4*)p + lane;
#pragma unroll
    for (int j = 0; j < 4; ++j) xr[64 * j] = v[j];
}
__device__ __forceinline__ void ld_row_bf16(const bf16* p, int lane, f32x4 (&v)[4]) {
    const GAS u32x2* xr = (const GAS u32x2*)p + lane;
#pragma unroll
    for (int j = 0; j < 4; ++j) { const u32x2 w = xr[64 * j]; v[j] = (f32x4){bflo(w.x), bfhi(w.x), bflo(w.y), bfhi(w.y)}; }
}
__device__ __forceinline__ void st_row_bf16(bf16* p, int lane, const f32x4 (&v)[4]) {
    GAS u32x2* xr = (GAS u32x2*)p + lane;
#pragma unroll
    for (int j = 0; j < 4; ++j) { u32x2 w; w.x = pk2(v[j].x, v[j].y); w.y = pk2(v[j].z, v[j].w); xr[64 * j] = w; }
}
__device__ __forceinline__ float row_sumsq(const f32x4 (&v)[4]) {
    float s = 0.f;
#pragma unroll
    for (int j = 0; j < 4; ++j) s += dot4(v[j], v[j]);
    return wave_sum(s);
}

__device__ __forceinline__ void p0_transpose_item(const float* W, int K, int ldn, int c0, int k0, bf16* WT, int r0, LAS float* scr, int lane) {
#pragma unroll 8
    for (int i = 0; i < 32; ++i) { const int kk = 2 * i + (lane >> 5); scr[kk * 33 + (lane & 31)] = W[(size_t)(k0 + kk) * ldn + c0 + (lane & 31)]; }
    LDS_WAIT(); asm volatile("" ::: "memory");
    const int c = lane & 7;
#pragma unroll
    for (int j = 0; j < 4; ++j) { const int n = (lane >> 3) + 8 * j; const LAS float* s = scr + (8 * c) * 33 + n;
        v4u o; o.x = pk2(s[0 * 33], s[1 * 33]); o.y = pk2(s[2 * 33], s[3 * 33]); o.z = pk2(s[4 * 33], s[5 * 33]); o.w = pk2(s[6 * 33], s[7 * 33]);
        *(GAS v4u*)(WT + (size_t)(r0 + n) * K + k0 + 8 * c) = o; }
    LDS_WAIT(); asm volatile("" ::: "memory");
}
__device__ __forceinline__ bool p0_matrix(int& r, const float* W, int K, int ldn, int ncols, bf16* WT, int swiglu, LAS float* scr, int lane) {
    const int ncb = ncols / 32, nit = (K / 64) * ncb;
    if (r >= nit) { r -= nit; return false; }
    const int kb = r / ncb, cb = r % ncb, c0 = 32 * cb;
    int r0 = c0;
    if (swiglu) { const int isu = c0 >= DFF ? 1 : 0, j = c0 - isu * DFF; r0 = (j >> 7) * 256 + isu * 128 + (j & 127); }
    p0_transpose_item(W, K, ldn, c0, 64 * kb, WT, r0, scr, lane);
    return true;
}
__device__ __forceinline__ void p0_prologue(Frame& F) {
    const int gw = blockIdx.x * NWAVES + F.wave, NGW = F.G * NWAVES;
    {
        LAS float* csL = (LAS float*)(F.lds);
        LAS float* part = (LAS float*)(F.lds + 32768);
        for (int u = F.tid; u < 8 * 1024; u += NWAVES * 64) { const float c = F.in[I_C][u]; csL[u] = c / (1.0f + expf(-c)); }
        LDS_WAIT(); __syncthreads();
        float* MOD = (float*)(F.ws + WS_MOD);
        for (int it = blockIdx.x; it < 224; it += F.G) {
            const float* W; const float* bias; float* out; int N, n0;
            if (it < 192) { const int l = it / 96; N = 6144; n0 = 64 * (it % 96); W = F.in[I_MOD_W] + (size_t)l * 1024 * 6144; bias = F.in[I_MOD_B] + l * 6144; out = MOD + (size_t)l * 8 * 6144; }
            else { N = 2048; n0 = 64 * (it - 192); W = F.in[I_KV_MOD_W]; bias = F.in[I_KV_MOD_B]; out = MOD + (size_t)2 * 8 * 6144; }
            float acc[8];
#pragma unroll
            for (int b = 0; b < 8; ++b) acc[b] = 0.f;
            const int kbeg = 128 * F.wave;
#pragma unroll 8
            for (int k = 0; k < 128; ++k) { const float w = W[(size_t)(kbeg + k) * N + n0 + F.lane];
#pragma unroll
                for (int b = 0; b < 8; ++b) acc[b] += csL[b * 1024 + kbeg + k] * w; }
#pragma unroll
            for (int b = 0; b < 8; ++b) part[(F.wave * 8 + b) * 64 + F.lane] = acc[b];
            LDS_WAIT(); __syncthreads();
            { const int b = F.wave; float s = bias[n0 + F.lane];
#pragma unroll
              for (int w = 0; w < 8; ++w) s += part[(w * 8 + b) * 64 + F.lane];
              out[(size_t)b * N + n0 + F.lane] = s; }
            LDS_WAIT(); __syncthreads();
        }
        __syncthreads();
    }
    LAS float* scr = (LAS float*)(F.lds + RING_OFF + F.wave * 16384);
    constexpr int NITEMS = 16 * 96 + 16 * 32 + 16 * 64 + 16 * 32 + 16 * 32 + 2 * (16 * 176) + 2 * (44 * 32);
    for (int it = gw; it < NITEMS; it += NGW) {
        int r = it;
        if (p0_matrix(r, F.in[I_A_W_IN], 1024, M_IN, M_INP, (bf16*)(F.ws + WS_WA_IN), 0, scr, F.lane)) continue;
        if (p0_matrix(r, F.in[I_A_W_OUT], 1024, 1024, 1024, (bf16*)(F.ws + WS_WA_OUT), 0, scr, F.lane)) continue;
        if (p0_matrix(r, F.in[I_KV_W], 1024, KV_OUT, 2048, (bf16*)(F.ws + WS_WKV), 0, scr, F.lane)) continue;
        if (p0_matrix(r, F.in[I_B_W_Q], 1024, 1024, 1024, (bf16*)(F.ws + WS_WQ), 0, scr, F.lane)) continue;
        if (p0_matrix(r, F.in[I_B_W_OUT], 1024, 1024, 1024, (bf16*)(F.ws + WS_WBO), 0, scr, F.lane)) continue;
        if (p0_matrix(r, F.in[I_FFN_W_IN], 1024, 2 * DFF, 2 * DFF, (bf16*)(F.ws + WS_WFI), 1, scr, F.lane)) continue;
        if (p0_matrix(r, F.in[I_FFN_W_IN] + (size_t)1024 * 2 * DFF, 1024, 2 * DFF, 2 * DFF, (bf16*)(F.ws + WS_WFI + WFI_STRIDE), 1, scr, F.lane)) continue;
        if (p0_matrix(r, F.in[I_FFN_W_OUT], DFF, 1024, 1024, (bf16*)(F.ws + WS_WFO), 0, scr, F.lane)) continue;
        p0_matrix(r, F.in[I_FFN_W_OUT] + (size_t)DFF * 1024, DFF, 1024, 1024, (bf16*)(F.ws + WS_WFO + WFO_STRIDE), 0, scr, F.lane);
    }
}

constexpr int ROWS_PER_WAVE = 16;
#ifndef USE_DD
#define USE_DD 1
#endif
static_assert(M == 256 * NWAVES * ROWS_PER_WAVE, "row phases assume a 256-workgroup grid");

__device__ __forceinline__ void ld_par(const float* p, int lane, f32x4 (&v)[4]) { ld_row_f32(p, lane, v); }

__device__ __forceinline__ void stage_gate_w(Frame& F, const float* W, int ldn, int c0, int ncol) {
    LAS float* T = (LAS float*)F.lds;
    for (int u = F.tid; u < ncol * 1024; u += NWAVES * 64) { const int k = u / ncol, c = u % ncol; T[c * 1024 + k] = W[(size_t)k * ldn + c0 + c]; }
    LDS_WAIT(); __syncthreads();
}
__device__ __forceinline__ float gate_dot(Frame& F, const f32x4 (&h)[4], int c) {
    const LAS f32x4* T = (const LAS f32x4*)(F.lds) + c * 256 + F.lane;
    float s = 0.f;
#pragma unroll
    for (int j = 0; j < 4; ++j) s += dot4(h[j], T[64 * j]);
    return s;
}

__device__ __forceinline__ void row_phase_A(Frame& F) {
    stage_gate_w(F, F.in[I_A_W_IN], M_IN, M_INP, 8);
    const int gw = blockIdx.x * NWAVES + F.wave, m0 = gw * ROWS_PER_WAVE, b = m0 / SEQ, lane = F.lane;
    const float* mod = (const float*)(F.ws + WS_MOD) + (size_t)b * 6144;
    f32x4 gs[4], sh[4];
    { f32x4 g[4], sc[4]; ld_par(F.in[I_MIX_PRE_G], lane, g); ld_par(mod + 1024, lane, sc); ld_par(mod, lane, sh);
#pragma unroll
      for (int j = 0; j < 4; ++j) gs[j] = g[j] * (sc[j] + 1.0f); }
    bf16* XN = (bf16*)(F.ws + WS_RA);
    float* IG = (float*)(F.ws + WS_IG); float* LFp = (float*)(F.ws + WS_LF);
    const float gb = F.in[I_A_GATE_B][lane & 7];
    for (int i = 0; i < ROWS_PER_WAVE; ++i) {
        const int m = m0 + i, s = m - b * SEQ;
        f32x4 v[4]; ld_row_f32(F.in[I_X] + (size_t)m * D, lane, v);
        const float r = 1.0f / sqrtf(row_sumsq(v) * (1.0f / D) + EPS);
#pragma unroll
        for (int j = 0; j < 4; ++j) v[j] = v[j] * r * gs[j] + sh[j];
        st_row_bf16(XN + (size_t)m * D, lane, v);
        float mine = 0.f;
#pragma unroll 1
        for (int c = 0; c < 8; ++c) { const float t = wave_sum(gate_dot(F, v, c)); if (lane == c) mine = t; }
        if (lane < 8) { const float a = softcapf(mine + gb);
            if (lane < 4) IG[(size_t)(b * MH + lane) * SEQ + s] = a; else LFp[(size_t)(b * MH + lane - 4) * SEQ + s] = logsigf(a); }
    }
    __syncthreads();
}
__device__ __forceinline__ void row_phase_B(Frame& F) {
    const int gw = blockIdx.x * NWAVES + F.wave, m0 = gw * ROWS_PER_WAVE, b = m0 / SEQ, lane = F.lane;
    f32x4 hg[4]; ld_par(F.in[I_A_HNORM_G], lane, hg);
    const bf16* HH = (const bf16*)(F.ws + WS_RB); const bf16* PROJ = (const bf16*)(F.ws + WS_RP); bf16* Y = (bf16*)(F.ws + WS_RA);
    const float* DD = (const float*)(F.ws + WS_F2);
    for (int i = 0; i < ROWS_PER_WAVE; ++i) {
        const int m = m0 + i, s = m - b * SEQ;
        f32x4 v[4], o[4]; ld_row_bf16(HH + (size_t)m * D, lane, v); ld_row_bf16(PROJ + (size_t)m * M_INP + 2048, lane, o);
#pragma unroll
        for (int j = 0; j < 4; ++j) { const float dd = USE_DD ? DD[(size_t)(b * MH + j) * SEQ + s] : 1.0f;
            const float r = 1.0f / sqrtf(wave_sum(dot4(v[j], v[j])) * (1.0f / MV) + EPS * dd * dd);
            f32x4 sg; sg.x = 1.0f / (1.0f + expf(-o[j].x)); sg.y = 1.0f / (1.0f + expf(-o[j].y)); sg.z = 1.0f / (1.0f + expf(-o[j].z)); sg.w = 1.0f / (1.0f + expf(-o[j].w));
            v[j] = sg * (v[j] * r * hg[j]); }
        st_row_bf16(Y + (size_t)m * D, lane, v);
    }
}
template <int MODE>
__device__ __forceinline__ void row_phase_C(Frame& F, const float* x_old, const float* post_g, const float* gate_base  ,
                                            const float* pre_g, const float* scsh_base  ) {
    if (MODE == 1) stage_gate_w(F, F.in[I_KV_W], KV_OUT, 2048, 16);
    const int gw = blockIdx.x * NWAVES + F.wave, m0 = gw * ROWS_PER_WAVE, b = m0 / SEQ, lane = F.lane;
    f32x4 gp[4];
    { f32x4 pg[4], gt[4]; ld_par(post_g, lane, pg); ld_par(gate_base + (size_t)b * 6144, lane, gt);
#pragma unroll
      for (int j = 0; j < 4; ++j) gp[j] = pg[j] * gt[j]; }
    f32x4 gs[4], sh[4], gs2[4], sh2[4];
    if (MODE != 2) { f32x4 g[4], sc[4]; ld_par(pre_g, lane, g); ld_par(scsh_base + (size_t)b * 6144 + 1024, lane, sc); ld_par(scsh_base + (size_t)b * 6144, lane, sh);
#pragma unroll
      for (int j = 0; j < 4; ++j) gs[j] = g[j] * (sc[j] + 1.0f); }
    if (MODE == 1) { const float* kvm = (const float*)(F.ws + WS_MOD) + (size_t)2 * 8 * 6144 + (size_t)b * 2048;
      f32x4 g[4], sc[4]; ld_par(F.in[I_KV_NORM_G], lane, g); ld_par(kvm + 1024, lane, sc); ld_par(kvm, lane, sh2);
#pragma unroll
      for (int j = 0; j < 4; ++j) gs2[j] = g[j] * (sc[j] + 1.0f); }
    const bf16* Z = (const bf16*)(F.ws + WS_RD); bf16* XN = (bf16*)(F.ws + WS_RA); bf16* XN2 = (bf16*)(F.ws + WS_RB);
    float* LOGF = (float*)(F.ws + WS_LOGF);
    const float fb = (MODE == 1) ? F.in[I_KV_FGATE_B][lane & 15] : 0.f;
    for (int i = 0; i < ROWS_PER_WAVE; ++i) {
        const int m = m0 + i, s = m - b * SEQ;
        f32x4 z[4], x[4]; ld_row_bf16(Z + (size_t)m * D, lane, z); ld_row_f32(x_old + (size_t)m * D, lane, x);
        const float rz = 1.0f / sqrtf(row_sumsq(z) * (1.0f / D) + EPS);
#pragma unroll
        for (int j = 0; j < 4; ++j) x[j] = x[j] + gp[j] * (z[j] * rz);
        st_row_f32(F.out + (size_t)m * D, lane, x);
        if (MODE != 2) {
            const float r = 1.0f / sqrtf(row_sumsq(x) * (1.0f / D) + EPS);
            f32x4 h[4];
#pragma unroll
            for (int j = 0; j < 4; ++j) h[j] = x[j] * r * gs[j] + sh[j];
            st_row_bf16(XN + (size_t)m * D, lane, h);
            if (MODE == 1) {
#pragma unroll
                for (int j = 0; j < 4; ++j) h[j] = x[j] * r * gs2[j] + sh2[j];
                st_row_bf16(XN2 + (size_t)m * D, lane, h);
                float mine = 0.f;
#pragma unroll 1
                for (int c = 0; c < 16; ++c) { const float t = wave_sum(gate_dot(F, h, c)); if (lane == c) mine = t; }
                if (lane < 16) LOGF[(size_t)(b * FH + lane) * SEQ + s] = logsigf(mine + fb);
            }
        }
    }
    if (MODE == 1) __syncthreads();
}
__device__ __forceinline__ void cumsum_f2(Frame& F) {
    const int gw = blockIdx.x * NWAVES + F.wave;
    if (gw >= BATCH * FH) return;
    const float* src = (const float*)(F.ws + WS_LOGF) + (size_t)gw * SEQ + 64 * F.lane; float* dst = (float*)(F.ws + WS_F2) + (size_t)gw * SEQ + 64 * F.lane;
    float tot = 0.f;
    for (int i = 0; i < 16; ++i) { const f32x4 v = *(const gf32x4*)(src + 4 * i); tot += (v.x + v.y) + (v.z + v.w); }
    float incl = tot;
#pragma unroll
    for (int o = 1; o < 64; o <<= 1) { const float t = __shfl_up(incl, o); if (F.lane >= o) incl += t; }
    float run = incl - tot;
    for (int i = 0; i < 16; ++i) { const f32x4 v = *(const gf32x4*)(src + 4 * i); f32x4 o;
        run += v.x; o.x = run * LOG2E; run += v.y; o.y = run * LOG2E; run += v.z; o.z = run * LOG2E; run += v.w; o.w = run * LOG2E;
        *(gf32x4*)(dst + 4 * i) = o; }
}

__device__ __forceinline__ void mlstm_naive(Frame& F) {
    LAS float* qs = (LAS float*)(F.lds);
    LAS float* ks = qs + 32 * 128;
    LAS float* vs = ks + 32 * 128;
    LAS float* nums = vs + 32 * 256;
    LAS float* gts = nums + 32 * 257;
    LAS float* ems = gts + 96;
    const bf16* PROJ = (const bf16*)(F.ws + WS_RP); bf16* HH = (bf16*)(F.ws + WS_RB);
    const float* IG = (const float*)(F.ws + WS_IG); const float* LFp = (const float*)(F.ws + WS_LF);
    const float qscale = 0.08838834764831845f;
    for (int bh = blockIdx.x; bh < BATCH * MH; bh += F.G) {
        const int b = bh / MH, h = bh % MH;
        float C[128];
#pragma unroll
        for (int k = 0; k < 128; ++k) C[k] = 0.f;
        float mrun = 0.f;
        for (int s0 = 0; s0 < SEQ; s0 += 32) {
            __syncthreads();
            for (int u = F.tid; u < 32 * 128; u += NWAVES * 64) { const int t = u >> 7, k = u & 127; const bf16* row = PROJ + (size_t)(b * SEQ + s0 + t) * M_INP;
                qs[u] = bf2f(row[h * MQK + k]) * qscale; ks[u] = bf2f(row[512 + h * MQK + k]); }
            for (int u = F.tid; u < 32 * 256; u += NWAVES * 64) { const int t = u >> 8, c = u & 255; vs[u] = bf2f(PROJ[(size_t)(b * SEQ + s0 + t) * M_INP + 1024 + h * MV + c]); }
            if (F.tid < 32) { gts[F.tid] = IG[(size_t)bh * SEQ + s0 + F.tid]; gts[32 + F.tid] = LFp[(size_t)bh * SEQ + s0 + F.tid]; }
            LDS_WAIT(); __syncthreads();
            if (F.tid <= 256) {
                for (int t = 0; t < 32; ++t) {
                    const float ig = gts[t], lf = gts[32 + t];
                    const float mn = fmaxf(lf + mrun, ig), fd = expf(lf + mrun - mn), ie = expf(ig - mn); mrun = mn;
                    const float sv = ie * (F.tid < 256 ? vs[t * 256 + F.tid] : 1.0f);
                    float num = 0.f;
                    const LAS f32x4* q4 = (const LAS f32x4*)(qs + t * 128); const LAS f32x4* k4 = (const LAS f32x4*)(ks + t * 128);
#pragma unroll
                    for (int k = 0; k < 32; ++k) { const f32x4 qq = q4[k], kk = k4[k];
                        C[4 * k + 0] = fd * C[4 * k + 0] + sv * kk.x; num += qq.x * C[4 * k + 0];
                        C[4 * k + 1] = fd * C[4 * k + 1] + sv * kk.y; num += qq.y * C[4 * k + 1];
                        C[4 * k + 2] = fd * C[4 * k + 2] + sv * kk.z; num += qq.z * C[4 * k + 2];
                        C[4 * k + 3] = fd * C[4 * k + 3] + sv * kk.w; num += qq.w * C[4 * k + 3]; }
                    nums[t * 257 + F.tid] = num;
                    if (F.tid == 256) ems[t] = expf(-mn);
                }
            }
            LDS_WAIT(); __syncthreads();
            for (int u = F.tid; u < 32 * 256; u += NWAVES * 64) { const int t = u >> 8, c = u & 255;
                const float den = fmaxf(fabsf(nums[t * 257 + 256]), ems[t]);
                HH[(size_t)(b * SEQ + s0 + t) * D + h * MV + c] = (bf16)f2bf(nums[t * 257 + c] / den); }
        }
        __syncthreads();
    }
}

__device__ __forceinline__ void attn_naive(Frame& F) {
    LAS float* Ks = (LAS float*)(F.lds);
    LAS float* Vs = Ks + 64 * 64;
    LAS float* Fs = Vs + 64 * 64;
    const bf16* Q = (const bf16*)(F.ws + WS_RP); const bf16* K = Q + (size_t)M * D; const bf16* V = K + (size_t)M * D; bf16* O = (bf16*)(F.ws + WS_RP);
    const float* F2 = (const float*)(F.ws + WS_F2);
    for (int u = blockIdx.x; u < BATCH * FH * (SEQ / 512); u += F.G) {
        const int bh = u / (SEQ / 512), qb = u % (SEQ / 512), b = bh / FH, h = bh % FH;
        const int t = qb * 512 + F.tid; const size_t rowq = (size_t)(b * SEQ + t) * D + h * FHD;
        float q[64], o[64];
#pragma unroll
        for (int d = 0; d < 64; ++d) { q[d] = bf2f(Q[rowq + d]); o[d] = 0.f; }
        const float ft = F2[(size_t)bh * SEQ + t];
        float mrun = -1e30f, l = 0.f;
        const int ntile = (qb * 512 + 512) / 64;
        for (int kt = 0; kt < ntile; ++kt) {
            __syncthreads();
            for (int e = F.tid; e < 64 * 64; e += NWAVES * 64) { const int j = e >> 6, d = e & 63; const size_t a = (size_t)(b * SEQ + kt * 64 + j) * D + h * FHD + d; Ks[e] = bf2f(K[a]); Vs[e] = bf2f(V[a]); }
            if (F.tid < 64) Fs[F.tid] = F2[(size_t)bh * SEQ + kt * 64 + F.tid];
            LDS_WAIT(); __syncthreads();
            for (int j = 0; j < 64; ++j) {
                if (kt * 64 + j <= t) {
                    float x = 0.f; const LAS f32x4* k4 = (const LAS f32x4*)(Ks + j * 64);
#pragma unroll
                    for (int d = 0; d < 16; ++d) { const f32x4 kk = k4[d]; x += q[4 * d] * kk.x + q[4 * d + 1] * kk.y + q[4 * d + 2] * kk.z + q[4 * d + 3] * kk.w; }
                    x += ft - Fs[j];
                    const float mn = fmaxf(mrun, x), al = exp2f(mrun - mn), p = exp2f(x - mn); mrun = mn; l = l * al + p;
                    const LAS f32x4* v4 = (const LAS f32x4*)(Vs + j * 64);
#pragma unroll
                    for (int d = 0; d < 16; ++d) { const f32x4 vv = v4[d]; o[4 * d] = o[4 * d] * al + p * vv.x; o[4 * d + 1] = o[4 * d + 1] * al + p * vv.y; o[4 * d + 2] = o[4 * d + 2] * al + p * vv.z; o[4 * d + 3] = o[4 * d + 3] * al + p * vv.w; }
                }
            }
        }
        const float rl = 1.0f / l;
#pragma unroll
        for (int d = 0; d < 64; ++d) O[rowq + d] = (bf16)f2bf(o[d] * rl);
        __syncthreads();
    }
}

namespace fa {
typedef short bf16x8 __attribute__((ext_vector_type(8)));
typedef short s16x4 __attribute__((ext_vector_type(4)));
typedef float f32x16 __attribute__((ext_vector_type(16)));
typedef unsigned u32x4 __attribute__((ext_vector_type(4)));
typedef float f32x4v __attribute__((ext_vector_type(4)));
typedef float f32x2_t __attribute__((ext_vector_type(2))); typedef __bf16 bf16x2_t __attribute__((ext_vector_type(2)));
constexpr int DM = 1024, QB = 256, KVBLK = 64, SLOTB = 8192;
constexpr int L_K = 0, L_V = 2 * SLOTB, L_WS = 4 * SLOTB, L_OST = L_WS + 8 * 64 * 4, L_F = L_OST + 8 * 4096, L_END = L_F + 4096 * 4;
constexpr float NEG = -1.0e30f;
__device__ __forceinline__ int crow(int r, int hi) { return (r & 3) + 8 * (r >> 2) + 4 * hi; }
__device__ __forceinline__ unsigned cvtpk(float lo, float hi) { f32x2_t v = {lo, hi}; bf16x2_t b = __builtin_convertvector(v, bf16x2_t); return __builtin_bit_cast(unsigned, b); }
__device__ __forceinline__ void glds16(const void* gsrc, unsigned lds_dst) { unsigned keep;
    asm volatile("s_mov_b32 %0, m0\n\ts_mov_b32 m0, %2\n\ts_nop 0\n\tglobal_load_lds_dwordx4 %1, off\n\ts_mov_b32 m0, %0" : "=&s"(keep) : "v"(gsrc), "s"(lds_dst) : "memory"); }

__device__ __forceinline__ void qkt(f32x16& p0, f32x16& p1, const LAS char* Kslot, const bf16x8 (&qr)[4], int r32, int hi) {
    const LAS char* kb = Kslot + hi * 1024 + r32 * 16;
    const f32x16 z = {};
#pragma unroll
    for (int d0 = 0; d0 < 4; ++d0) {
        const bf16x8 b0 = *(const LAS bf16x8*)(kb + d0 * 2048);
        const bf16x8 b1 = *(const LAS bf16x8*)(kb + d0 * 2048 + 512);
        if (d0 == 0) { p0 = __builtin_amdgcn_mfma_f32_32x32x16_bf16(b0, qr[0], z, 0, 0, 0); p1 = __builtin_amdgcn_mfma_f32_32x32x16_bf16(b1, qr[0], z, 0, 0, 0); }
        else { p0 = __builtin_amdgcn_mfma_f32_32x32x16_bf16(b0, qr[d0], p0, 0, 0, 0); p1 = __builtin_amdgcn_mfma_f32_32x32x16_bf16(b1, qr[d0], p1, 0, 0, 0); }
    }
}
__device__ __forceinline__ void pv(f32x16 (&o)[2], int vb, bf16x8 pa0, bf16x8 pa1, bf16x8 pa2, bf16x8 pa3) {
#pragma unroll
    for (int d0 = 0; d0 < 2; ++d0) { s16x4 lo[4], hi[4];
#pragma unroll
        for (int ks = 0; ks < 4; ++ks) {
            asm volatile("ds_read_b64_tr_b16 %0,%1 offset:%c2" : "=&v"(lo[ks]) : "v"(vb), "i"(d0 * 4096 + ks * 1024) : "memory");
            asm volatile("ds_read_b64_tr_b16 %0,%1 offset:%c2" : "=&v"(hi[ks]) : "v"(vb), "i"(d0 * 4096 + ks * 1024 + 512) : "memory"); }
        asm volatile("s_waitcnt lgkmcnt(0)" ::: "memory"); __builtin_amdgcn_sched_barrier(0);
#define FA_PK(k) (bf16x8){lo[k][0], lo[k][1], lo[k][2], lo[k][3], hi[k][0], hi[k][1], hi[k][2], hi[k][3]}
        o[d0] = __builtin_amdgcn_mfma_f32_32x32x16_bf16(pa0, FA_PK(0), o[d0], 0, 0, 0);
        o[d0] = __builtin_amdgcn_mfma_f32_32x32x16_bf16(pa1, FA_PK(1), o[d0], 0, 0, 0);
        o[d0] = __builtin_amdgcn_mfma_f32_32x32x16_bf16(pa2, FA_PK(2), o[d0], 0, 0, 0);
        o[d0] = __builtin_amdgcn_mfma_f32_32x32x16_bf16(pa3, FA_PK(3), o[d0], 0, 0, 0);
#undef FA_PK
    }
}
__device__ __forceinline__ float rowmax32(const f32x16& p0, const f32x16& p1) {
    float a = __builtin_fmaxf(p0[0], p1[0]), b = __builtin_fmaxf(p0[1], p1[1]);
#pragma unroll
    for (int r = 2; r < 16; r += 2) { a = __builtin_fmaxf(a, __builtin_fmaxf(p0[r], p1[r])); b = __builtin_fmaxf(b, __builtin_fmaxf(p0[r + 1], p1[r + 1])); }
    float m = __builtin_fmaxf(a, b);
    auto rr = __builtin_amdgcn_permlane32_swap(__float_as_uint(m), __float_as_uint(m), false, false);
    return __builtin_fmaxf(__uint_as_float(rr[0]), __uint_as_float(rr[1]));
}

template <bool SKIP>
__device__ __forceinline__ void attn_unit(int b, int h, int qb, const bf16* Q, const bf16* K, const bf16* V, bf16* O, const float* F2row, float qk2, LAS unsigned char* shm) {
    const int tid = threadIdx.x, lane = tid & 63, r32 = lane & 31, hi = lane >> 5; const int wid = __builtin_amdgcn_readfirstlane(tid >> 6);
    const long rowbase = (long)b * SEQ; const int q0 = qb * QB;
    const bf16* Qw = Q + (rowbase + q0 + wid * 32) * DM + h * 64;
    const bf16* Kh = K + rowbase * DM + h * 64; const bf16* Vh = V + rowbase * DM + h * 64;
    const unsigned lds0 = (unsigned)(size_t)shm;
    LAS float* wsf = (LAS float*)(shm + L_WS) + wid * 64;
    LAS float* Fl = (LAS float*)(shm + L_F);
    const int NT = (q0 + QB) / KVBLK;
    const float fref = F2row[q0];
    int tb = 0;
    if (SKIP) {
        int lo_ = 0, hi_ = NT - 4;
        while (lo_ < hi_) { const int mid = (lo_ + hi_) >> 1; const float bnd = fref - F2row[mid * KVBLK + KVBLK - 1] + qk2; if (bnd >= -160.0f) hi_ = mid; else lo_ = mid + 1; }
        tb = lo_;
    }
    const bf16* ksrc = Kh + (long)lane * DM + wid * 8;
    const bf16* vsrc = Vh + (long)(16 * (wid & 3) + (lane >> 2)) * DM + (wid >> 2) * 32 + (lane & 3) * 8;
    const unsigned kdst = lds0 + L_K + wid * 1024, vdst = lds0 + L_V + wid * 1024;
#define FA_DMA(t, slot) do { glds16(ksrc + (long)(t) * KVBLK * DM, (unsigned)__builtin_amdgcn_readfirstlane(kdst + (slot) * SLOTB)); \
                             glds16(vsrc + (long)(t) * KVBLK * DM, (unsigned)__builtin_amdgcn_readfirstlane(vdst + (slot) * SLOTB)); } while (0)
    FA_DMA(tb, 0);
    for (int i = tid; i < (NT - tb) * KVBLK; i += NWAVES * 64) Fl[i] = F2row[tb * KVBLK + i] - fref;
    bf16x8 qr[4];
#pragma unroll
    for (int d0 = 0; d0 < 4; ++d0) qr[d0] = *reinterpret_cast<const bf16x8*>(&Qw[(long)r32 * DM + d0 * 16 + hi * 8]);
    const int vb0 = (int)(lds0 + L_V) + ((lane >> 4) & 1) * 32 + (lane & 3) * 8 + (4 * hi + ((lane & 15) >> 2)) * 64;
    const int qrel = wid * 32 + r32;
    float mrow = NEG, l_reg = 0.f; f32x16 o[2]; o[0] = f32x16{}; o[1] = f32x16{};
    for (int t = tb; t < NT; ++t) {
        const int cur = (t - tb) & 1;
        asm volatile("s_waitcnt vmcnt(0) lgkmcnt(0)" ::: "memory"); __syncthreads();
        if (t + 1 < NT) FA_DMA(t + 1, cur ^ 1);
        f32x16 p0, p1;
        qkt(p0, p1, (const LAS char*)(shm + L_K + cur * SLOTB), qr, r32, hi);
        { const LAS f32x4v* F4 = (const LAS f32x4v*)(Fl + (t - tb) * KVBLK);
#pragma unroll
          for (int g = 0; g < 4; ++g) { const f32x4v b0 = F4[2 * g + hi], b1 = F4[8 + 2 * g + hi];
#pragma unroll
              for (int e = 0; e < 4; ++e) { p0[4 * g + e] -= b0[e]; p1[4 * g + e] -= b1[e]; } } }
        if (t >= NT - 4) { const int kb = 64 * (t - (NT - 4)) + 4 * hi;
#pragma unroll
            for (int r = 0; r < 16; ++r) { const int kv = kb + (r & 3) + 8 * (r >> 2); if (kv > qrel) p0[r] = NEG; if (kv + 32 > qrel) p1[r] = NEG; } }
        const float rm = rowmax32(p0, p1);
        const float mn = __builtin_fmaxf(mrow, rm), alpha = __builtin_amdgcn_exp2f(mrow - mn);
        float sacc = 0.f;
#pragma unroll
        for (int r = 0; r < 16; ++r) { p0[r] = __builtin_amdgcn_exp2f(p0[r] - mn); p1[r] = __builtin_amdgcn_exp2f(p1[r] - mn); sacc += p0[r] + p1[r]; }
        l_reg = l_reg * alpha + sacc;
        if (__any(mn > mrow)) {
            if (hi == 0) wsf[r32] = alpha;
            asm volatile("s_waitcnt lgkmcnt(0)" ::: "memory");
#pragma unroll
            for (int r = 0; r < 16; ++r) { const float f = wsf[crow(r, hi)]; o[0][r] *= f; o[1][r] *= f; }
            asm volatile("s_waitcnt lgkmcnt(0)" ::: "memory");
        }
        mrow = mn;
        u32x4 pw0, pw1, pw2, pw3;
        pw0 = (u32x4){cvtpk(p0[0], p0[1]), cvtpk(p0[2], p0[3]), cvtpk(p0[4], p0[5]), cvtpk(p0[6], p0[7])};
        pw1 = (u32x4){cvtpk(p0[8], p0[9]), cvtpk(p0[10], p0[11]), cvtpk(p0[12], p0[13]), cvtpk(p0[14], p0[15])};
        pw2 = (u32x4){cvtpk(p1[0], p1[1]), cvtpk(p1[2], p1[3]), cvtpk(p1[4], p1[5]), cvtpk(p1[6], p1[7])};
        pw3 = (u32x4){cvtpk(p1[8], p1[9]), cvtpk(p1[10], p1[11]), cvtpk(p1[12], p1[13]), cvtpk(p1[14], p1[15])};
        pv(o, vb0 + cur * SLOTB, __builtin_bit_cast(bf16x8, pw0), __builtin_bit_cast(bf16x8, pw1), __builtin_bit_cast(bf16x8, pw2), __builtin_bit_cast(bf16x8, pw3));
    }
#undef FA_DMA
    { auto rr = __builtin_amdgcn_permlane32_swap(__float_as_uint(l_reg), __float_as_uint(l_reg), false, false); l_reg = __uint_as_float(rr[0]) + __uint_as_float(rr[1]); }
    if (hi == 0) wsf[32 + r32] = l_reg;
    asm volatile("s_waitcnt lgkmcnt(0)" ::: "memory");
    float rli[16];
#pragma unroll
    for (int r = 0; r < 16; ++r) rli[r] = __builtin_amdgcn_rcpf(wsf[32 + crow(r, hi)]);
    bf16* Ow = O + (rowbase + q0 + wid * 32) * DM + h * 64;
    { LAS bf16* stg = (LAS bf16*)(shm + L_OST) + wid * 2048;
#pragma unroll
      for (int r = 0; r < 16; ++r) { const int orow = crow(r, hi);
#pragma unroll
          for (int d0 = 0; d0 < 2; ++d0) stg[orow * 64 + d0 * 32 + r32] = (bf16)f2bf(o[d0][r] * rli[r]); }
      asm volatile("s_waitcnt lgkmcnt(0)" ::: "memory");
#pragma unroll
      for (int i = 0; i < 4; ++i) { const int row = i * 8 + (lane >> 3), ch = lane & 7; const u32x4 v = *(const LAS u32x4*)(stg + row * 64 + ch * 8); *(u32x4*)(Ow + (long)row * DM + ch * 8) = v; } }
    asm volatile("s_waitcnt lgkmcnt(0)" ::: "memory"); __syncthreads();
}
}

template <bool SKIP>
__device__ __forceinline__ void attn_phase(Frame& F) {
    const bf16* Q = (const bf16*)(F.ws + WS_RP); const bf16* K = Q + (size_t)M * D; const bf16* V = K + (size_t)M * D; bf16* O = (bf16*)(F.ws + WS_RP);
    const int bx = blockIdx.x, vcu = (bx % 8) * (F.G / 8) + bx / 8;
    const int bh = vcu >> 1, half = vcu & 1, b = bh / FH, h = bh % FH;
    const float* F2row = (const float*)(F.ws + WS_F2) + (size_t)bh * SEQ;
    float qk2 = 0.f;
    if (SKIP) { const gu32* nb = F.ctl + CW_NORM + 4 * bh;
        const float qn2 = __uint_as_float(__hip_atomic_load(nb + 0, RLX_AGENT)) + __uint_as_float(__hip_atomic_load(nb + 1, RLX_AGENT));
        const float kn2 = __uint_as_float(__hip_atomic_load(nb + 2, RLX_AGENT)) + __uint_as_float(__hip_atomic_load(nb + 3, RLX_AGENT));
        qk2 = 2.0f * sqrtf(qn2 * kn2) * 1.01f + 1.0f; }
    for (int i = 0; i < 8; ++i) {
        const int base = 2 * (i >> 1) + half, qb = (i & 1) ? 15 - base : base;
        fa::attn_unit<SKIP>(b, h, qb, Q, K, V, O, F2row, qk2, F.lds);
    }
}

namespace ml {
typedef short bf16x8 __attribute__((ext_vector_type(8)));
typedef short s16x4 __attribute__((ext_vector_type(4)));
typedef float f32x16 __attribute__((ext_vector_type(16)));
typedef float f32x4v __attribute__((ext_vector_type(4)));
typedef unsigned u32x4 __attribute__((ext_vector_type(4)));
typedef unsigned u32x2v __attribute__((ext_vector_type(2)));
constexpr int NCH = 64, L = 64, PLD = 3072;
constexpr int L_Q = 0, L_K = 32768, L_V = 65536, L_CB = 73728, CB_STRIDE = 272, CB_BYTES = 64 * CB_STRIDE, L_SCR = L_CB + 2 * CB_BYTES, SCR_BYTES = 2816;
static_assert(L_SCR + 8 * SCR_BYTES <= 131072, "mLSTM LDS map");
constexpr float SC_LOG2 = -3.5f;
__device__ __forceinline__ s16x4 trd(int addr, int off) { s16x4 v; asm volatile("ds_read_b64_tr_b16 %0,%1 offset:%c2" : "=&v"(v) : "v"(addr), "i"(off) : "memory"); return v; }
#define ML_TR(dst, addr, off) asm volatile("ds_read_b64_tr_b16 %0,%1 offset:%c2" : "=&v"(dst) : "v"(addr), "i"(off) : "memory")

__device__ __forceinline__ void mlstm_phase(Frame& F) {
    LAS unsigned char* shm = F.lds;
    const int tid = F.tid, lane = F.lane, r32 = lane & 31, hi = lane >> 5, bit = (lane >> 4) & 1, q4 = (lane & 15) >> 2, p4 = lane & 3;
    const int wid = F.wave;
    const int bx = blockIdx.x, vcu = (bx % 8) * (F.G / 8) + bx / 8, bh = vcu >> 3, slice = vcu & 7, b = bh / MH, h = bh % MH;
    const bf16* PROJ = (const bf16*)(F.ws + WS_RP);
    const bf16* qg = PROJ + (size_t)b * SEQ * PLD + h * MQK;
    const bf16* kg = PROJ + (size_t)b * SEQ * PLD + 512 + h * MQK;
    const bf16* vg = PROJ + (size_t)b * SEQ * PLD + 1024 + h * MV + slice * 32;
    bf16* NUM = (bf16*)(F.ws + WS_RB) + (size_t)b * SEQ * D + h * MV + slice * 32;
    float* DD = (float*)(F.ws + WS_F2) + (size_t)bh * SEQ;
    const float* IGp = (const float*)(F.ws + WS_IG) + (size_t)bh * SEQ; const float* LFp = (const float*)(F.ws + WS_LF) + (size_t)bh * SEQ;
    const unsigned lds0 = (unsigned)(size_t)shm;
    LAS float* scr = (LAS float*)(shm + L_SCR + wid * SCR_BYTES);
    const bf16* qsrc = qg + (size_t)lane * PLD + (2 * wid) * 8;
    const bf16* ksrc = kg + (size_t)lane * PLD + (2 * wid) * 8;
    const bf16* vsrc = vg + (size_t)(16 * (wid & 3) + (lane >> 2)) * PLD + (lane & 3) * 8;
#define ML_DMA(c, slot) do { const size_t ro_ = (size_t)(c) * L * PLD; \
        fa::glds16(qsrc + ro_, (unsigned)__builtin_amdgcn_readfirstlane(lds0 + L_Q + (slot) * 16384 + (2 * wid) * 1024)); \
        fa::glds16(qsrc + ro_ + 8, (unsigned)__builtin_amdgcn_readfirstlane(lds0 + L_Q + (slot) * 16384 + (2 * wid + 1) * 1024)); \
        fa::glds16(ksrc + ro_, (unsigned)__builtin_amdgcn_readfirstlane(lds0 + L_K + (slot) * 16384 + (2 * wid) * 1024)); \
        fa::glds16(ksrc + ro_ + 8, (unsigned)__builtin_amdgcn_readfirstlane(lds0 + L_K + (slot) * 16384 + (2 * wid + 1) * 1024)); \
        if (wid < 4) fa::glds16(vsrc + ro_, (unsigned)__builtin_amdgcn_readfirstlane(lds0 + L_V + (slot) * 4096 + wid * 1024)); } while (0)
    for (int i = tid; i < CB_BYTES / 4; i += NWAVES * 64) ((LAS unsigned*)(shm + L_CB))[i] = 0u;
    ML_DMA(0, 0);
    float ig_n = IGp[lane], lf_n = LFp[lane];
    float mrun = 0.f;
    f32x16 C0 = {}, C1 = {};
    const unsigned ones_w = (r32 == 0) ? 0x3F803F80u : 0u;
    const bf16x8 ONES = __builtin_bit_cast(bf16x8, (u32x4){ones_w, ones_w, ones_w, ones_w});
    asm volatile("s_waitcnt vmcnt(0) lgkmcnt(0)" ::: "memory"); __builtin_amdgcn_s_barrier();
    for (int c = 0; c < NCH; ++c) {
        const int slot = c & 1;
        const float ig = ig_n, lf = lf_n;
        float bsum = lf;
#pragma unroll
        for (int o = 1; o < 64; o <<= 1) { const float t = __shfl_up(bsum, o); if (lane >= o) bsum += t; }
        const float g = ig - bsum;
        float pm = g;
#pragma unroll
        for (int o = 1; o < 64; o <<= 1) { const float t = __shfl_up(pm, o); if (lane >= o) pm = __builtin_fmaxf(pm, t); }
        const float Mt = __builtin_fmaxf(mrun, pm);
        const float M63 = __shfl(Mt, 63), b63 = __shfl(bsum, 63);
        if (c + 1 < NCH) { ML_DMA(c + 1, slot ^ 1); ig_n = IGp[(c + 1) * L + lane]; lf_n = LFp[(c + 1) * L + lane]; }
        const int vb = (int)(lds0 + L_V + slot * 4096) + bit * 32 + p4 * 8 + (4 * hi + q4) * 64;
        if (wid < 4) {
            const int ti = wid >> 1, ci = wid & 1;
            scr[lane] = g; scr[64 + lane] = __builtin_amdgcn_exp2f((mrun - Mt) * LOG2E + SC_LOG2);
            const float Mt_l = __shfl(Mt, r32 + 32 * ti);
            const LAS unsigned char* Qs = shm + L_Q + slot * 16384; const LAS unsigned char* Ks = shm + L_K + slot * 16384;
            const LAS unsigned char* Cb = shm + L_CB + slot * CB_BYTES;
            bf16x8 qf[8];
#pragma unroll
            for (int ks = 0; ks < 8; ++ks) qf[ks] = *(const LAS bf16x8*)(Qs + (2 * ks + hi) * 1024 + (r32 + 32 * ti) * 16);
            f32x16 acc = {};
#pragma unroll
            for (int ks = 0; ks < 8; ++ks) { const bf16x8 cb = *(const LAS bf16x8*)(Cb + (r32 + 32 * ci) * CB_STRIDE + 32 * ks + 16 * hi); acc = __builtin_amdgcn_mfma_f32_32x32x16_bf16(qf[ks], cb, acc, 0, 0, 0); }
            asm volatile("s_waitcnt lgkmcnt(0)" ::: "memory");
            { const LAS f32x4v* A4 = (const LAS f32x4v*)(scr + 64);
#pragma unroll
              for (int gg = 0; gg < 4; ++gg) { const f32x4v av = A4[8 * ti + 2 * gg + hi];
#pragma unroll
                  for (int e = 0; e < 4; ++e) acc[4 * gg + e] *= av[e]; } }
            bf16x8 pa[4];
#pragma unroll
            for (int si = 0; si < 2; ++si) {
                if (si <= ti) {
                    f32x16 st = {};
#pragma unroll
                    for (int ks = 0; ks < 8; ++ks) { const bf16x8 kf = *(const LAS bf16x8*)(Ks + (2 * ks + hi) * 1024 + (r32 + 32 * si) * 16); st = __builtin_amdgcn_mfma_f32_32x32x16_bf16(kf, qf[ks], st, 0, 0, 0); }
                    const LAS f32x4v* G4 = (const LAS f32x4v*)(scr);
                    float pv_[16];
#pragma unroll
                    for (int gg = 0; gg < 4; ++gg) { const f32x4v gv = G4[8 * si + 2 * gg + hi];
#pragma unroll
                        for (int e = 0; e < 4; ++e) { const int r = 4 * gg + e; const float w = __builtin_amdgcn_exp2f((gv[e] - Mt_l) * LOG2E + SC_LOG2);
                            float val = st[r] * w; if (si == ti && (e + 8 * gg + 4 * hi) > r32) val = 0.f; pv_[r] = val; } }
                    u32x4 w0 = (u32x4){fa::cvtpk(pv_[0], pv_[1]), fa::cvtpk(pv_[2], pv_[3]), fa::cvtpk(pv_[4], pv_[5]), fa::cvtpk(pv_[6], pv_[7])};
                    u32x4 w1 = (u32x4){fa::cvtpk(pv_[8], pv_[9]), fa::cvtpk(pv_[10], pv_[11]), fa::cvtpk(pv_[12], pv_[13]), fa::cvtpk(pv_[14], pv_[15])};
                    pa[2 * si] = __builtin_bit_cast(bf16x8, w0); pa[2 * si + 1] = __builtin_bit_cast(bf16x8, w1);
                }
            }
            if (ci == 0) {
#pragma unroll
                for (int ks = 0; ks < 4; ++ks) {
                    if (ks < 2 * ti + 2) { s16x4 lo, hh; ML_TR(lo, vb, ks * 1024); ML_TR(hh, vb, ks * 1024 + 512);
                        asm volatile("s_waitcnt lgkmcnt(0)" ::: "memory"); __builtin_amdgcn_sched_barrier(0);
                        const bf16x8 vf = (bf16x8){lo[0], lo[1], lo[2], lo[3], hh[0], hh[1], hh[2], hh[3]};
                        acc = __builtin_amdgcn_mfma_f32_32x32x16_bf16(pa[ks], vf, acc, 0, 0, 0); }
                }
            } else {
#pragma unroll
                for (int ks = 0; ks < 4; ++ks) if (ks < 2 * ti + 2) acc = __builtin_amdgcn_mfma_f32_32x32x16_bf16(pa[ks], ONES, acc, 0, 0, 0);
            }
            asm volatile("s_waitcnt vmcnt(0)" ::: "memory");
            if (ci == 0) {
                LAS bf16* stg = (LAS bf16*)((LAS unsigned char*)scr + 768);
#pragma unroll
                for (int r = 0; r < 16; ++r) stg[fa::crow(r, hi) * 32 + r32] = (bf16)f2bf(acc[r]);
                asm volatile("s_waitcnt lgkmcnt(0)" ::: "memory");
#pragma unroll
                for (int i = 0; i < 2; ++i) { const int row = i * 16 + (lane >> 2), pc = lane & 3; const u32x4 v = *(const LAS u32x4*)(stg + row * 32 + pc * 8);
                    *(u32x4*)(NUM + (size_t)(c * L + 32 * ti + row) * D + pc * 8) = v; }
            } else {
                scr[192 + lane] = __builtin_amdgcn_exp2f(-(bsum + Mt) * LOG2E);
                asm volatile("s_waitcnt lgkmcnt(0)" ::: "memory");
                if (slice == 0 && r32 == 0) {
                    const LAS f32x4v* E4 = (const LAS f32x4v*)(scr + 192);
#pragma unroll
                    for (int gg = 0; gg < 4; ++gg) { const f32x4v ev = E4[8 * ti + 2 * gg + hi];
#pragma unroll
                        for (int e = 0; e < 4; ++e) DD[c * L + 32 * ti + e + 8 * gg + 4 * hi] = __builtin_fmaxf(__builtin_fabsf(acc[4 * gg + e]), ev[e]); }
                }
            }
        } else {
            const int dkt = wid - 4;
            scr[128 + lane] = __builtin_amdgcn_exp2f((g - M63) * LOG2E);
            const float a_c = __builtin_amdgcn_exp2f((mrun - M63) * LOG2E);
#pragma unroll
            for (int r = 0; r < 16; ++r) { C0[r] *= a_c; C1[r] *= a_c; }
            const int kb = (int)(lds0 + L_K + slot * 16384) + (4 * dkt + 2 * bit + (p4 >> 1)) * 1024 + (4 * hi + q4) * 16 + (p4 & 1) * 8;
            asm volatile("s_waitcnt lgkmcnt(0)" ::: "memory");
            const LAS f32x4v* W4 = (const LAS f32x4v*)(scr + 128);
#pragma unroll
            for (int ks = 0; ks < 4; ++ks) {
                s16x4 klo, khi, vlo, vhi; ML_TR(klo, kb, ks * 256); ML_TR(khi, kb, ks * 256 + 128); ML_TR(vlo, vb, ks * 1024); ML_TR(vhi, vb, ks * 1024 + 512);
                const f32x4v wl = W4[4 * ks + hi], wh = W4[4 * ks + 2 + hi];
                asm volatile("s_waitcnt lgkmcnt(0)" ::: "memory"); __builtin_amdgcn_sched_barrier(0);
                u32x4 aw;
                aw.x = fa::cvtpk(bf2f((unsigned short)klo[0]) * wl[0], bf2f((unsigned short)klo[1]) * wl[1]); aw.y = fa::cvtpk(bf2f((unsigned short)klo[2]) * wl[2], bf2f((unsigned short)klo[3]) * wl[3]);
                aw.z = fa::cvtpk(bf2f((unsigned short)khi[0]) * wh[0], bf2f((unsigned short)khi[1]) * wh[1]); aw.w = fa::cvtpk(bf2f((unsigned short)khi[2]) * wh[2], bf2f((unsigned short)khi[3]) * wh[3]);
                const bf16x8 af = __builtin_bit_cast(bf16x8, aw);
                const bf16x8 vf = (bf16x8){vlo[0], vlo[1], vlo[2], vlo[3], vhi[0], vhi[1], vhi[2], vhi[3]};
                C0 = __builtin_amdgcn_mfma_f32_32x32x16_bf16(af, vf, C0, 0, 0, 0);
                C1 = __builtin_amdgcn_mfma_f32_32x32x16_bf16(af, ONES, C1, 0, 0, 0);
            }
            LAS unsigned char* Cn = shm + L_CB + (slot ^ 1) * CB_BYTES;
#pragma unroll
            for (int gg = 0; gg < 4; ++gg) {
                u32x2v w0; w0.x = fa::cvtpk(C0[4 * gg], C0[4 * gg + 1]); w0.y = fa::cvtpk(C0[4 * gg + 2], C0[4 * gg + 3]);
                u32x2v w1; w1.x = fa::cvtpk(C1[4 * gg], C1[4 * gg + 1]); w1.y = fa::cvtpk(C1[4 * gg + 2], C1[4 * gg + 3]);
                *(LAS u32x2v*)(Cn + r32 * CB_STRIDE + (32 * dkt + 8 * gg + 4 * hi) * 2) = w0;
                *(LAS u32x2v*)(Cn + (r32 + 32) * CB_STRIDE + (32 * dkt + 8 * gg + 4 * hi) * 2) = w1;
            }
            asm volatile("s_waitcnt vmcnt(0)" ::: "memory");
        }
        mrun = b63 + M63;
        asm volatile("s_waitcnt lgkmcnt(0)" ::: "memory"); __builtin_amdgcn_s_barrier(); asm volatile("" ::: "memory");
    }
#undef ML_DMA
    asm volatile("s_waitcnt vmcnt(0) lgkmcnt(0)" ::: "memory"); __syncthreads();
}
#undef ML_TR
}

constexpr int NPHASES = 17;
struct Args { const float* in[21]; float* out; unsigned char* ws; int ph_lo, ph_hi, use_bar, pad; };
__global__ void __launch_bounds__(NWAVES * 64, 2) yoco_fwd(Args args) {
    extern __shared__ __attribute__((aligned(16))) unsigned char lds[];
    Frame F;
    F.lds = (LAS unsigned char*)lds;
    F.MISC = (volatile LAS unsigned*)(F.lds + MISC_OFF);
    F.tid = threadIdx.x; F.lane = F.tid & 63; F.wave = __builtin_amdgcn_readfirstlane(F.tid >> 6);
    F.G = gridDim.x;
    F.ws = args.ws; F.out = args.out; F.ctl = (gu32*)(args.ws + WS_CTL);
    F.in = args.in;
    for (int u = F.tid; u < (LDS_BYTES - LDSCTL_OFF) / 4; u += NWAVES * 64) ((LAS unsigned*)(F.lds + LDSCTL_OFF))[u] = 0u;
    __syncthreads();
    XcdBarrier bar; bar.bar = (unsigned*)(F.ctl + CW_BAR); bar.x = 0; bar.st = nullptr;
    if (args.use_bar) bar = xcd_barrier_post((unsigned*)(F.ctl + CW_BAR), F.MISC + 8);

    const int lo = args.ph_lo, hi = args.ph_hi;
#define IN(k) (lo <= (k) && (k) < hi)
#define SEAM(k) do { if (IN(k) && (k) > lo) xcd_barrier(bar); } while (0)
#define WSP(off) (args.ws + (off))
#define MODP ((const float*)(args.ws + WS_MOD))
#define GEMM_BF16(Aoff, Boff, N_, K_, Ooff, ldc_, split_, stride_, scale_) do { \
        pg8::Gemm g{(const pg8::bf16_t*)WSP(Aoff), (const pg8::bf16_t*)WSP(Boff), M, (N_), (K_)}; pg8::StaticOrder S; S.init(M, (N_), F.G, (int)blockIdx.x); \
        pg8::EpiBf16 E{(pg8::bf16_t*)WSP(Ooff), (ldc_), (split_), (size_t)(stride_), (scale_)}; \
        pg8::gemm_phase<pg8::EpiBf16, pg8::StaticOrder, true, true>(F.lds + RING_OFF, g, S, E); } while (0)
#define GEMM_SWIGLU(Aoff, Boff, Ooff) do { \
        pg8::Gemm g{(const pg8::bf16_t*)WSP(Aoff), (const pg8::bf16_t*)WSP(Boff), M, 2 * DFF, D}; pg8::StaticOrder S; S.init(M, 2 * DFF, F.G, (int)blockIdx.x); \
        pg8::EpiSwiGLU E{(pg8::bf16_t*)WSP(Ooff), DFF}; \
        pg8::gemm_phase<pg8::EpiSwiGLU, pg8::StaticOrder, true, true>(F.lds + RING_OFF, g, S, E); } while (0)

    SEAM(0);  if (IN(0)) p0_prologue(F);
    SEAM(1);  if (IN(1)) row_phase_A(F);
    SEAM(2);  if (IN(2)) GEMM_BF16(WS_RA, WS_WA_IN, M_INP, D, WS_RP, M_INP, 0, 0, 1.f);
    SEAM(3);  if (IN(3)) ml::mlstm_phase(F);
    SEAM(4);  if (IN(4)) row_phase_B(F);
    SEAM(5);  if (IN(5)) GEMM_BF16(WS_RA, WS_WA_OUT, D, D, WS_RD, D, 0, 0, 1.f);
    SEAM(6);  if (IN(6)) row_phase_C<0>(F, args.in[I_X], args.in[I_MIX_POST_G], MODP + 2048, args.in[I_FFN_PRE_G], MODP + 3072);
    SEAM(7);  if (IN(7)) GEMM_SWIGLU(WS_RA, WS_WFI, WS_RP);
    SEAM(8);  if (IN(8)) GEMM_BF16(WS_RP, WS_WFO, D, DFF, WS_RD, D, 0, 0, 1.f);
    SEAM(9);  if (IN(9)) row_phase_C<1>(F, args.out, args.in[I_FFN_POST_G], MODP + 5120, args.in[I_MIX_PRE_G] + 1024, MODP + (size_t)8 * 6144);
    SEAM(10); if (IN(10)) { cumsum_f2(F);
                            GEMM_BF16(WS_RB, WS_WKV, 2048, D, WS_RP + 64 * MiB, D, 1024, (size_t)M * D, 1.f);
                            GEMM_BF16(WS_RA, WS_WQ, D, D, WS_RP, D, 1024, 0, QSCALE2); }
    SEAM(11); if (IN(11)) attn_phase<false>(F);
    SEAM(12); if (IN(12)) GEMM_BF16(WS_RP, WS_WBO, D, D, WS_RD, D, 0, 0, 1.f);
    SEAM(13); if (IN(13)) row_phase_C<0>(F, args.out, args.in[I_MIX_POST_G] + 1024, MODP + (size_t)8 * 6144 + 2048, args.in[I_FFN_PRE_G] + 1024, MODP + (size_t)8 * 6144 + 3072);
    SEAM(14); if (IN(14)) GEMM_SWIGLU(WS_RA, WS_WFI + WFI_STRIDE, WS_RP);
    SEAM(15); if (IN(15)) GEMM_BF16(WS_RP, WS_WFO + WFO_STRIDE, D, DFF, WS_RD, D, 0, 0, 1.f);
    SEAM(16); if (IN(16)) row_phase_C<2>(F, args.out, args.in[I_FFN_POST_G] + 1024, MODP + (size_t)8 * 6144 + 5120, nullptr, nullptr);
}

#ifndef MK_PER_PHASE
#define MK_PER_PHASE 0
#endif
extern "C" void kernel_launch(void* const* d_in, const int* in_sizes, int n_in, void* d_out, int out_size, void* d_ws, size_t ws_size, hipStream_t stream) {
    static int grid = 0;
    if (grid == 0) {
        if (n_in != 21 || in_sizes[0] != M * D || out_size != M * D || ws_size < WS_END) { fprintf(stderr, "kernel_launch: unexpected shapes: n_in %d in0 %d out %d ws %zu (need %zu)\n", n_in, n_in > 0 ? in_sizes[0] : -1, out_size, ws_size, (size_t)WS_END); grid = -1; return; }
        int dev = 0, cus = 0, per_cu = 0;
        if (hipGetDevice(&dev) != hipSuccess || hipDeviceGetAttribute(&cus, hipDeviceAttributeMultiprocessorCount, dev) != hipSuccess) { grid = -1; return; }
        if (hipFuncSetAttribute((const void*)yoco_fwd, hipFuncAttributeMaxDynamicSharedMemorySize, LDS_BYTES) != hipSuccess) { fprintf(stderr, "kernel_launch: hipFuncSetAttribute failed\n"); grid = -1; return; }
        if (hipOccupancyMaxActiveBlocksPerMultiprocessor(&per_cu, (const void*)yoco_fwd, NWAVES * 64, LDS_BYTES) != hipSuccess || per_cu < 1)
            fprintf(stderr, "kernel_launch: note: occupancy query reports %d workgroups per CU\n", per_cu);
        (void)hipGetLastError();
        grid = cus;
        if (grid != 256) { fprintf(stderr, "kernel_launch: built for 256 CUs, device has %d\n", grid); }
    }
    if (grid < 0) return;
    if (hipMemsetAsync((char*)d_ws + WS_CTL, 0, CTL_ZERO_BYTES, stream) != hipSuccess) { fprintf(stderr, "kernel_launch: hipMemsetAsync failed\n"); return; }
    Args a{};
    for (int i = 0; i < 21; ++i) a.in[i] = (const float*)d_in[i];
    a.out = (float*)d_out; a.ws = (unsigned char*)d_ws;
#if MK_PER_PHASE
    for (int ph = 0; ph < NPHASES; ++ph) {
        a.ph_lo = ph; a.ph_hi = ph + 1; a.use_bar = 0;
        hipLaunchKernelGGL(yoco_fwd, dim3(256), dim3(NWAVES * 64), LDS_BYTES, stream, a);
    }
#else
    a.ph_lo = 0; a.ph_hi = NPHASES; a.use_bar = 1;
    hipLaunchKernelGGL(yoco_fwd, dim3(256), dim3(NWAVES * 64), LDS_BYTES, stream, a);
#endif
    const hipError_t le = hipPeekAtLastError();
    if (le != hipSuccess) fprintf(stderr, "kernel_launch: launch failed: %s\n", hipGetErrorName(le));
}
```

```cpp
#define PROBE_MASK 0
#include <hip/hip_runtime.h>
#include <hip/hip_bf16.h>
#include <cstdio>
#include <cstdint>
#include <cmath>
namespace pg8 {
#define PG8_LAS __attribute__((address_space(3)))
typedef unsigned short bf16_t;
typedef short bf16x8 __attribute__((ext_vector_type(8)));
typedef float f32x4 __attribute__((ext_vector_type(4)));
typedef unsigned u32x4 __attribute__((ext_vector_type(4)));
constexpr int BM = 256, BK = 64, HALF = 128, HTB = HALF * BK * 2  , STAGE_BYTES = 8 * HTB, NXCD = 8, WGM = 8;

__host__ __device__ __forceinline__ int lds_byte(int r, int c) { const int st = (r >> 4) * 2 + (c >> 5), rr = r & 15, cc = c & 31, ob = rr * 64 + cc * 2; return st * 1024 + (ob ^ (((ob >> 9) & 1) << 5)); }
__host__ __device__ __forceinline__ void stage_rc(int b, int& R, int& C) { const int st = b / 1024, sb = b % 1024, swz = sb ^ (((sb >> 9) & 1) << 5); R = (st >> 1) * 16 + swz / 64; C = (st & 1) * 32 + (swz % 64) / 2; }
__host__ __device__ __forceinline__ int perm32(int rho) { const int n = rho >> 4, i = rho & 15; return 8 * (i >> 2) + 4 * n + (i & 3); }

struct Unit { int pm, pn; };
struct Gemm { const bf16_t* A; const bf16_t* Bt; int M, N, K; };

struct StaticOrder {
    int nM, nN, nwg, G, c;
    __host__ __device__ void init(int M, int N, int G_, int c_) { nM = M / BM; nN = N / BM; nwg = nM * nN; G = G_; c = c_; }
    __host__ __device__ bool next(int i, Unit& u) const {
        const long L = (long)i * G + c; if (L >= nwg) return false;
        int wgid = (int)L; { const int q = nwg / NXCD, r = nwg % NXCD, xcd = wgid % NXCD, off = wgid / NXCD; wgid = (xcd < r ? xcd * (q + 1) : r * (q + 1) + (xcd - r) * q) + off; }
        const int nig = WGM * nN, gid = wgid / nig, fm = gid * WGM, gsz = (nM - fm) < WGM ? (nM - fm) : WGM;
        u.pm = fm + ((wgid % nig) % gsz); u.pn = (wgid % nig) / gsz; return true;
    }
    __device__ __forceinline__ void a_ready(const Unit&) const {}
    __device__ __forceinline__ void done(const Unit&) const {}
};

__device__ __forceinline__ unsigned cvt_pk_bf16(float lo, float hi) { unsigned r; asm volatile("v_cvt_pk_bf16_f32 %0, %1, %2" : "=v"(r) : "v"(lo), "v"(hi)); return r; }
struct EpiBf16 {
    static constexpr bool PERM = true, AFTER_DRAIN = false;
    bf16_t* O; int ldc; int split_cols; size_t split_stride; float scale0; unsigned* nrm; int nrm_which;
    __device__ __forceinline__ void operator()(const f32x4 (&acc)[2][2][4][2], const Unit& u, int wr, int wc, int fr, int fq) const {
        const int row0 = u.pm * BM + wr * 64 + fr; int colt = u.pn * BM; bf16_t* base = O;
        float sc = 1.f; int t = 0; if (split_cols) { t = colt / split_cols; base += (size_t)t * split_stride; colt -= t * split_cols; if (t == 0) sc = scale0; }
        const int col0 = colt + wc * 32 + 8 * fq;
        float nmax[2] = {0.f, 0.f};
#pragma unroll
        for (int ai = 0; ai < 2; ++ai)
#pragma unroll
            for (int m = 0; m < 4; ++m) { bf16_t* rowp = base + (size_t)(row0 + ai * HALF + m * 16) * ldc + col0;
#pragma unroll
                for (int bj = 0; bj < 2; ++bj) { f32x4 v0 = acc[ai][bj][m][0], v1 = acc[ai][bj][m][1];
                    v0 = v0 * sc; v1 = v1 * sc; u32x4 w; w.x = cvt_pk_bf16(v0[0], v0[1]); w.y = cvt_pk_bf16(v0[2], v0[3]); w.z = cvt_pk_bf16(v1[0], v1[1]); w.w = cvt_pk_bf16(v1[2], v1[3]);
                    *(u32x4*)(rowp + bj * HALF) = w;
                    if (nrm) { float ss = (v0[0] * v0[0] + v0[1] * v0[1]) + (v0[2] * v0[2] + v0[3] * v0[3]) + (v1[0] * v1[0] + v1[1] * v1[1]) + (v1[2] * v1[2] + v1[3] * v1[3]);
                        ss += __shfl_xor(ss, 16); ss += __shfl_xor(ss, 32); nmax[bj] = __builtin_fmaxf(nmax[bj], ss); } } }
        if (nrm && t == 0) {
#pragma unroll
            for (int bj = 0; bj < 2; ++bj) { float v = nmax[bj];
                v = __builtin_fmaxf(v, __shfl_xor(v, 1)); v = __builtin_fmaxf(v, __shfl_xor(v, 2)); v = __builtin_fmaxf(v, __shfl_xor(v, 4)); v = __builtin_fmaxf(v, __shfl_xor(v, 8));
                if (fr == 0 && fq == 0) { const int bq = (u.pm * BM) / 4096, head = (colt + 128 * bj + 32 * wc) >> 6;
                    atomicMax(nrm + ((bq * 16 + head) * 4 + nrm_which * 2 + (wc & 1)), __float_as_uint(v)); } }
        }
    }
};
__device__ __forceinline__ float silu_mul(float g, float u) { return g * u * __builtin_amdgcn_rcpf(1.0f + __builtin_amdgcn_exp2f(-1.4426950408889634f * g)); }
struct EpiSwiGLU {
    static constexpr bool PERM = true, AFTER_DRAIN = false;
    bf16_t* O; int ldc;
    __device__ __forceinline__ void operator()(const f32x4 (&acc)[2][2][4][2], const Unit& u, int wr, int wc, int fr, int fq) const {
        const int row0 = u.pm * BM + wr * 64 + fr; const int col0 = u.pn * HALF + wc * 32 + 8 * fq;
#pragma unroll
        for (int ai = 0; ai < 2; ++ai)
#pragma unroll
            for (int m = 0; m < 4; ++m) { bf16_t* rowp = O + (size_t)(row0 + ai * HALF + m * 16) * ldc + col0;
                const f32x4 g0 = acc[ai][0][m][0], g1 = acc[ai][0][m][1], u0 = acc[ai][1][m][0], u1 = acc[ai][1][m][1];
                u32x4 w; w.x = cvt_pk_bf16(silu_mul(g0[0], u0[0]), silu_mul(g0[1], u0[1])); w.y = cvt_pk_bf16(silu_mul(g0[2], u0[2]), silu_mul(g0[3], u0[3]));
                w.z = cvt_pk_bf16(silu_mul(g1[0], u1[0]), silu_mul(g1[1], u1[1])); w.w = cvt_pk_bf16(silu_mul(g1[2], u1[2]), silu_mul(g1[3], u1[3]));
                *(u32x4*)rowp = w; }
    }
};

template <class Epi, class Sched, bool ALIGN_EPI = false, bool SP2 = false>
__device__ __forceinline__ void gemm_phase(PG8_LAS unsigned char* lds, const Gemm g, const Sched& S, const Epi& E) {
    const int tid = threadIdx.x, wid = __builtin_amdgcn_readfirstlane(tid >> 6), lane = tid & 63, wr = wid >> 2, wc = wid & 3, fr = lane & 15, fq = lane >> 4;
    const int K = g.K, nt = K / BK;
    unsigned voffA[2], voffB[2];
#pragma unroll
    for (int i = 0; i < 2; ++i) { int R, C; stage_rc(tid * 16 + i * 8192, R, C); const int Rb = Epi::PERM ? ((R & ~31) + perm32(R & 31)) : R;
        voffA[i] = (unsigned)(R * K + C) * 2u; voffB[i] = (unsigned)(Rb * K + C) * 2u; }
    const size_t kstep = (size_t)(BK * 2);
    const size_t hstep = (size_t)HALF * K * 2;
    const size_t tstep = 2 * hstep;
    const unsigned ldsw = (unsigned)wid * 1024u;
    const int aoff = lds_byte(wr * 64 + fr, fq * 8), boff = lds_byte(wc * 32 + fr, fq * 8);
#define PG8_SA(b, h) (((b) * 2 + (h)) * HTB)
#define PG8_SB(b, h) ((4 + (b) * 2 + (h)) * HTB)
#define PG8_STAGE(bufoff, gbase, voff) do { _Pragma("unroll") for (int _i = 0; _i < 2; ++_i) \
        __builtin_amdgcn_global_load_lds((const unsigned*)((const char*)(gbase) + (voff)[_i]), (PG8_LAS unsigned*)(lds + (bufoff) + ldsw + _i * 8192), 16, 0, 0); } while (0)
#define PG8_LDA(dst, b, h) do { _Pragma("unroll") for (int m = 0; m < 4; ++m) _Pragma("unroll") for (int k = 0; k < 2; ++k) dst[m][k] = *(const PG8_LAS bf16x8*)(lds + PG8_SA(b, h) + aoff + m * 2048 + k * 1024); } while (0)
#define PG8_LDB(dst, b, h) do { _Pragma("unroll") for (int n = 0; n < 2; ++n) _Pragma("unroll") for (int k = 0; k < 2; ++k) dst[n][k] = *(const PG8_LAS bf16x8*)(lds + PG8_SB(b, h) + boff + n * 2048 + k * 1024); } while (0)
#define PG8_MMA(ai, bj, At, Bt) do { __builtin_amdgcn_s_setprio(1); _Pragma("unroll") for (int m = 0; m < 4; ++m) _Pragma("unroll") for (int n = 0; n < 2; ++n) _Pragma("unroll") for (int k = 0; k < 2; ++k) \
        acc[ai][bj][m][n] = __builtin_amdgcn_mfma_f32_16x16x32_bf16(Bt[n][k], At[m][k], acc[ai][bj][m][n], 0, 0, 0); __builtin_amdgcn_s_setprio(0); } while (0)
#define PG8_WAIT_V(n) asm volatile("s_waitcnt vmcnt(" #n ")" ::: "memory")
#define PG8_WAIT_L(n) asm volatile("s_waitcnt lgkmcnt(" #n ")" ::: "memory")
#define PG8_BAR __builtin_amdgcn_s_barrier()
#define PG8_SCHED __builtin_amdgcn_sched_barrier(0)
    Unit cur, nxt; int ui = 0;
    if (!S.next(0, cur)) return;
    f32x4 acc[2][2][4][2];
#pragma unroll
    for (int a = 0; a < 2; ++a)
#pragma unroll
        for (int b = 0; b < 2; ++b)
#pragma unroll
            for (int m = 0; m < 4; ++m)
#pragma unroll
                for (int n = 0; n < 2; ++n) acc[a][b][m][n] = (f32x4){0.f, 0.f, 0.f, 0.f};
    bf16x8 At[4][2], B0[2][2], B1[2][2];
    const char* cA = (const char*)g.A + (size_t)cur.pm * tstep; const char* cB = (const char*)g.Bt + (size_t)cur.pn * tstep;
    S.a_ready(cur);
    if constexpr (SP2) {
        PG8_STAGE(PG8_SB(0, 0), cB, voffB); PG8_STAGE(PG8_SB(0, 1), cB + hstep, voffB); PG8_STAGE(PG8_SA(0, 0), cA, voffA); PG8_STAGE(PG8_SA(0, 1), cA + hstep, voffA);
        if (wr == 1) PG8_BAR;
        PG8_WAIT_V(2); PG8_BAR;
        PG8_STAGE(PG8_SB(1, 0), cB + kstep, voffB); PG8_STAGE(PG8_SA(1, 0), cA + kstep, voffA); PG8_STAGE(PG8_SB(1, 1), cB + hstep + kstep, voffB);
        PG8_WAIT_V(6); PG8_BAR;
    } else {
        PG8_STAGE(PG8_SB(0, 0), cB, voffB); PG8_STAGE(PG8_SA(0, 0), cA, voffA); PG8_STAGE(PG8_SB(0, 1), cB + hstep, voffB); PG8_STAGE(PG8_SA(0, 1), cA + hstep, voffA);
        if (wr == 1) PG8_BAR;
        PG8_WAIT_V(4); PG8_BAR;
        PG8_STAGE(PG8_SB(1, 0), cB + kstep, voffB); PG8_STAGE(PG8_SA(1, 0), cA + kstep, voffA); PG8_STAGE(PG8_SB(1, 1), cB + hstep + kstep, voffB);
        PG8_WAIT_V(6); PG8_BAR;
    }
    for (;;) {
        const bool has_next = S.next(ui + 1, nxt);
        const char* nA = has_next ? (const char*)g.A + (size_t)nxt.pm * tstep : cA; const char* nB = has_next ? (const char*)g.Bt + (size_t)nxt.pn * tstep : cB;
        for (int t = 0; t < nt; t += 2) {
            const bool last = (t == nt - 2);
            const char* a1 = cA + (size_t)(t + 1) * kstep;
            const char* a2 = last ? nA : cA + (size_t)(t + 2) * kstep; const char* b2 = last ? nB : cB + (size_t)(t + 2) * kstep;
            const char* a3 = a2 + kstep; const char* b3 = b2 + kstep;
            if (last && has_next) S.a_ready(nxt);
            if constexpr (SP2) {
            PG8_LDB(B0, 0, 0); PG8_LDB(B1, 0, 1); PG8_SCHED; PG8_LDA(At, 0, 0); PG8_STAGE(PG8_SA(1, 1), a1 + hstep, voffA);
            PG8_WAIT_V(8); PG8_WAIT_L(0); PG8_BAR; PG8_MMA(0, 0, At, B0); PG8_MMA(0, 1, At, B1); PG8_BAR; PG8_SCHED;
            PG8_LDA(At, 0, 1); PG8_STAGE(PG8_SB(0, 0), b2, voffB); PG8_STAGE(PG8_SB(0, 1), b2 + hstep, voffB); PG8_STAGE(PG8_SA(0, 0), a2, voffA);
            PG8_WAIT_V(8); PG8_WAIT_L(0); PG8_BAR; PG8_MMA(1, 0, At, B0); PG8_MMA(1, 1, At, B1); PG8_BAR; PG8_SCHED;
            PG8_LDB(B0, 1, 0); PG8_LDB(B1, 1, 1); PG8_SCHED; PG8_LDA(At, 1, 0); PG8_STAGE(PG8_SA(0, 1), a2 + hstep, voffA);
            PG8_WAIT_V(8); PG8_WAIT_L(0); PG8_BAR; PG8_MMA(0, 0, At, B0); PG8_MMA(0, 1, At, B1); PG8_BAR; PG8_SCHED;
            PG8_LDA(At, 1, 1); PG8_STAGE(PG8_SB(1, 0), b3, voffB); PG8_STAGE(PG8_SB(1, 1), b3 + hstep, voffB); PG8_STAGE(PG8_SA(1, 0), a3, voffA);
            PG8_WAIT_V(8); PG8_WAIT_L(0); PG8_BAR; PG8_MMA(1, 0, At, B0); PG8_MMA(1, 1, At, B1); PG8_BAR; PG8_SCHED;
            } else {
            PG8_LDB(B0, 0, 0); PG8_SCHED; PG8_LDA(At, 0, 0); PG8_STAGE(PG8_SA(1, 1), a1 + hstep, voffA);
            PG8_WAIT_L(8); PG8_BAR; PG8_WAIT_L(0); PG8_MMA(0, 0, At, B0); PG8_BAR; PG8_SCHED;
            PG8_LDB(B1, 0, 1); PG8_STAGE(PG8_SB(0, 0), b2, voffB);
            PG8_BAR; PG8_WAIT_L(0); PG8_MMA(0, 1, At, B1); PG8_BAR;
            PG8_LDA(At, 0, 1); PG8_STAGE(PG8_SA(0, 0), a2, voffA);
            PG8_BAR; PG8_WAIT_L(0); PG8_MMA(1, 0, At, B0); PG8_BAR; PG8_SCHED;
            PG8_STAGE(PG8_SB(0, 1), b2 + hstep, voffB);
            PG8_WAIT_V(6); PG8_BAR; PG8_MMA(1, 1, At, B1); PG8_BAR;
            PG8_LDB(B0, 1, 0); PG8_SCHED; PG8_LDA(At, 1, 0); PG8_STAGE(PG8_SA(0, 1), a2 + hstep, voffA);
            PG8_WAIT_L(8); PG8_BAR; PG8_WAIT_L(0); PG8_MMA(0, 0, At, B0); PG8_BAR; PG8_SCHED;
            PG8_LDB(B1, 1, 1); PG8_STAGE(PG8_SB(1, 0), b3, voffB);
            PG8_BAR; PG8_WAIT_L(0); PG8_MMA(0, 1, At, B1); PG8_BAR;
            PG8_LDA(At, 1, 1); PG8_STAGE(PG8_SA(1, 0), a3, voffA);
            PG8_BAR; PG8_WAIT_L(0); PG8_MMA(1, 0, At, B0); PG8_BAR; PG8_SCHED;
            PG8_STAGE(PG8_SB(1, 1), b3 + hstep, voffB);
            PG8_WAIT_V(6); PG8_BAR; PG8_MMA(1, 1, At, B1); PG8_BAR;
            }
        }
        if constexpr (ALIGN_EPI) { if (wr == 0) PG8_BAR; }
        if constexpr (!Epi::AFTER_DRAIN) { E(acc, cur, wr, wc, fr, fq); S.done(cur); }
        if (!has_next) break;
#pragma unroll
        for (int a = 0; a < 2; ++a)
#pragma unroll
            for (int b = 0; b < 2; ++b)
#pragma unroll
                for (int m = 0; m < 4; ++m)
#pragma unroll
                    for (int n = 0; n < 2; ++n) acc[a][b][m][n] = (f32x4){0.f, 0.f, 0.f, 0.f};
        cur = nxt; cA = nA; cB = nB; ++ui;
        if constexpr (ALIGN_EPI) { if (wr == 1) PG8_BAR; }
    }
    PG8_WAIT_V(0);
    if constexpr (!ALIGN_EPI) { if (wr == 0) PG8_BAR; }
    PG8_BAR;
    if constexpr (Epi::AFTER_DRAIN) { E.fused(acc, cur, wr, wc, fr, fq, lds, wid, lane); S.done(cur); }
#undef PG8_SA
#undef PG8_SB
#undef PG8_STAGE
#undef PG8_LDA
#undef PG8_LDB
#undef PG8_MMA
#undef PG8_WAIT_V
#undef PG8_WAIT_L
#undef PG8_BAR
#undef PG8_SCHED
}
}
#define GAS __attribute__((address_space(1)))
#define LAS __attribute__((address_space(3)))
typedef unsigned short bf16;
typedef unsigned v4u __attribute__((ext_vector_type(4)));
typedef float f32x4 __attribute__((ext_vector_type(4)));
typedef short bf16x8 __attribute__((ext_vector_type(8)));
typedef GAS unsigned gu32;
typedef GAS unsigned long long gu64;
#define RLX_AGENT __ATOMIC_RELAXED, __HIP_MEMORY_SCOPE_AGENT
#define LDS_WAIT() asm volatile("s_waitcnt lgkmcnt(0)" ::: "memory")
#define VM_WAIT() asm volatile("s_waitcnt vmcnt(0)" ::: "memory")
__device__ __forceinline__ unsigned long long rt() { return __builtin_amdgcn_s_memrealtime(); }
__device__ __forceinline__ unsigned f2bf(float f) { unsigned u = __builtin_bit_cast(unsigned, f); return (u + 0x7fffu + ((u >> 16) & 1u)) >> 16; }
__device__ __forceinline__ unsigned pk2(float lo, float hi) { return f2bf(lo) | (f2bf(hi) << 16); }

#define XB_TMO      128
#define XB_XCNT(j)  (256  + 64 * (j))
#define XB_XSUB(j)  (1280 + 64 * (j))
#define XB_XGEN(j)  (2304 + 64 * (j))
#define XB_TOP      3328
#define XB_TOPGEN   3392
#define XCD_BAR_WORDS 3456
#define XB_SPIN_CAP (1u << 18)

__device__ __forceinline__ unsigned xb_ld(unsigned* p)              { return __hip_atomic_load(p, __ATOMIC_RELAXED, __HIP_MEMORY_SCOPE_AGENT); }
__device__ __forceinline__ unsigned xb_add(unsigned* p, unsigned v) { return __hip_atomic_fetch_add(p, v, __ATOMIC_RELAXED, __HIP_MEMORY_SCOPE_AGENT); }
__device__ __forceinline__ unsigned xb_xcc_id() { return (unsigned)__builtin_amdgcn_s_getreg((3 << 11) | 20) & 0xFu; }
#define XB_SPIN(cond, bar) do { unsigned _sp = 0; while (cond) { __builtin_amdgcn_s_sleep(1); \
    if ((++_sp & 255u) == 0u) { if (xb_ld(&(bar)[XB_TMO])) break; if (_sp > XB_SPIN_CAP) { atomicAdd(&(bar)[XB_TMO], 1u); break; } } } } while (0)

struct XcdBarrier {
    unsigned* bar; unsigned x;
    volatile LAS unsigned* st;
};

__device__ __forceinline__ XcdBarrier xcd_barrier_post(unsigned* bar, volatile LAS unsigned* st) {
    XcdBarrier b; b.bar = bar; b.x = xb_xcc_id(); b.st = st;
    if (threadIdx.x == 0) (void)xb_add(&bar[XB_XCNT(b.x)], 1u);
    return b;
}
__device__ __forceinline__ void xcd_barrier_complete(unsigned* bar, unsigned x, unsigned& nloc, unsigned& nx) {
    const unsigned G = gridDim.x * gridDim.y * gridDim.z;
    unsigned sum, cnt, mine, sp = 0u;
    for (;;) {
        sum = 0u; cnt = 0u; mine = 0u;
#pragma unroll
        for (unsigned j = 0; j < 16; ++j) { const unsigned c = xb_ld(&bar[XB_XCNT(j)]); sum += c; cnt += (c > 0u) ? 1u : 0u; mine = (j == x) ? c : mine; }
        if (sum == G) break;
        __builtin_amdgcn_s_sleep(1);
        if ((++sp & 255u) == 0u) { if (xb_ld(&bar[XB_TMO])) break; if (sp > XB_SPIN_CAP) { atomicAdd(&bar[XB_TMO], 1u); break; } }
    }
    nloc = mine > 0u ? mine : 1u; nx = cnt > 0u ? cnt : 1u;
}

__device__ __forceinline__ void xcd_barrier(const XcdBarrier& b) {
    asm volatile("s_waitcnt vmcnt(0)" ::: "memory");
    __syncthreads();
    if (threadIdx.x == 0) {
        unsigned* bar = b.bar;
        __builtin_amdgcn_s_waitcnt(0);
        unsigned nloc = b.st[0], nx = b.st[1];
        if (nloc == 0u) { xcd_barrier_complete(bar, b.x, nloc, nx); b.st[0] = nloc; b.st[1] = nx; }
        const unsigned old = xb_add(&bar[XB_XSUB(b.x)], 1u);
        const unsigned gen = old / nloc;
        if (old + 1u == (gen + 1u) * nloc) {
            __builtin_amdgcn_fence(__ATOMIC_RELEASE, "agent");
            asm volatile("s_waitcnt vmcnt(0)" ::: "memory");
            const unsigned og = xb_add(&bar[XB_TOP], 1u);
            const unsigned tg = og / nx;
            if (og + 1u == (tg + 1u) * nx) xb_add(&bar[XB_TOPGEN], 1u);
            else XB_SPIN(xb_ld(&bar[XB_TOPGEN]) == tg, bar);
            __builtin_amdgcn_fence(__ATOMIC_ACQUIRE, "agent");
            xb_add(&bar[XB_XGEN(b.x)], 1u);
            asm volatile("s_waitcnt vmcnt(0)" ::: "memory");
        } else {
            XB_SPIN(xb_ld(&bar[XB_XGEN(b.x)]) == gen, bar);
            __builtin_amdgcn_fence(__ATOMIC_ACQUIRE, "agent");
            asm volatile("s_waitcnt vmcnt(0)" ::: "memory");
        }
    }
    __syncthreads();
}
constexpr int NWAVES = 8;
constexpr int BATCH = 8, SEQ = 4096, D = 1024, M = BATCH * SEQ;
constexpr int MH = 4, MQK = 128, MV = 256, M_IN = 3080, M_INP = 3072;
constexpr int FH = 16, FHD = 64, KV_OUT = 2064;
constexpr int DFF = 2816;
constexpr float EPS = 1e-6f, GATE_CAP = 15.0f;
constexpr float LOG2E = 1.4426950408889634f;
constexpr float QSCALE2 = 0.125f * LOG2E;

constexpr size_t MiB = 1u << 20;
constexpr size_t WS_CTL = 0, CTL_ZERO_BYTES = 1 * MiB;
constexpr size_t WS_MOD = 1 * MiB;
constexpr size_t WS_IG = 2 * MiB, WS_LF = 2 * MiB + 512 * 1024;
constexpr size_t WS_LOGF = 3 * MiB, WS_F2 = 5 * MiB;
constexpr size_t WS_WA_IN = 8 * MiB, WS_WA_OUT = 14 * MiB, WS_WKV = 16 * MiB, WS_WQ = 20 * MiB, WS_WBO = 22 * MiB;
constexpr size_t WS_WFI = 24 * MiB, WFI_STRIDE = 11 * MiB;
constexpr size_t WS_WFO = 46 * MiB, WFO_STRIDE = 5632 * 1024;
constexpr size_t WS_RA = 64 * MiB, WS_RB = 128 * MiB, WS_RD = 192 * MiB, WS_RP = 256 * MiB, WS_RX = 448 * MiB, WS_END = 512 * MiB;
constexpr int CW_BAR = 4096, CW_NORM = 8192;

constexpr int RING_OFF = 0, RING_BYTES = 143360;
constexpr int LDSCTL_OFF = RING_BYTES, MISC_OFF = LDSCTL_OFF + 320;
constexpr int LDS_BYTES = 147456;

typedef GAS f32x4 gf32x4;
typedef unsigned u32x2 __attribute__((ext_vector_type(2)));
__device__ __forceinline__ float bf2f(unsigned short h) { return __builtin_bit_cast(float, (unsigned)h << 16); }
__device__ __forceinline__ float bflo(unsigned w) { return __builtin_bit_cast(float, w << 16); }
__device__ __forceinline__ float bfhi(unsigned w) { return __builtin_bit_cast(float, w & 0xffff0000u); }

struct Frame {
    LAS unsigned char* lds;
    volatile LAS unsigned* MISC;
    gu32* ctl;
    int tid, lane, wave, G;
    const float* const* in; float* out; unsigned char* ws;
};
enum { I_X = 0, I_C, I_MOD_W, I_MOD_B, I_MIX_PRE_G, I_MIX_POST_G, I_FFN_PRE_G, I_FFN_POST_G, I_FFN_W_IN, I_FFN_W_OUT, I_A_W_IN, I_A_GATE_B, I_A_HNORM_G, I_A_W_OUT,
       I_KV_NORM_G, I_KV_MOD_W, I_KV_MOD_B, I_KV_W, I_KV_FGATE_B, I_B_W_Q, I_B_W_OUT };

__device__ __forceinline__ float wave_sum(float v) {
#pragma unroll
    for (int o = 1; o < 64; o <<= 1) v += __shfl_xor(v, o);
    return v;
}
__device__ __forceinline__ float dot4(f32x4 a, f32x4 b) { return (a.x * b.x + a.y * b.y) + (a.z * b.z + a.w * b.w); }
__device__ __forceinline__ float softcapf(float a) { return GATE_CAP * tanhf(a * (1.0f / GATE_CAP)); }
__device__ __forceinline__ float logsigf(float x) { return fminf(x, 0.f) - log1pf(expf(-fabsf(x))); }

__device__ __forceinline__ void ld_row_f32(const float* p, int lane, f32x4 (&v)[4]) {
    const gf32x4* xr = (const gf32x4*)p + lane;
#pragma unroll
    for (int j = 0; j < 4; ++j) v[j] = xr[64 * j];
}
__device__ __forceinline__ void st_row_f32(float* p, int lane, const f32x4 (&v)[4]) {
    gf32x4* xr = (gf32x4*)p + lane;
#pragma unroll
    for (int j = 0; j < 4; ++j) xr[64 * j] = v[j];
}
__device__ __forceinline__ void ld_row_bf16(const bf16* p, int lane, f32x4 (&v)[4]) {
    const GAS u32x2* xr = (const GAS u32x2*)p + lane;
#pragma unroll
    for (int j = 0; j < 4; ++j) { const u32x2 w = xr[64 * j]; v[j] = (f32x4){bflo(w.x), bfhi(w.x), bflo(w.y), bfhi(w.y)}; }
}
__device__ __forceinline__ void st_row_bf16(bf16* p, int lane, const f32x4 (&v)[4]) {
    GAS u32x2* xr = (GAS u32x2*)p + lane;
#pragma unroll
    for (int j = 0; j < 4; ++j) { u32x2 w; w.x = pk2(v[j].x, v[j].y); w.y = pk2(v[j].z, v[j].w); xr[64 * j] = w; }
}
__device__ __forceinline__ float row_sumsq(const f32x4 (&v)[4]) {
    float s = 0.f;
#pragma unroll
    for (int j = 0; j < 4; ++j) s += dot4(v[j], v[j]);
    return wave_sum(s);
}

__device__ __forceinline__ void p0_transpose_item(const float* W, int K, int ldn, int c0, int k0, bf16* WT, int r0, LAS float* scr, int lane) {
#pragma unroll 8
    for (int i = 0; i < 32; ++i) { const int kk = 2 * i + (lane >> 5); scr[kk * 33 + (lane & 31)] = W[(size_t)(k0 + kk) * ldn + c0 + (lane & 31)]; }
    LDS_WAIT(); asm volatile("" ::: "memory");
    const int c = lane & 7;
#pragma unroll
    for (int j = 0; j < 4; ++j) { const int n = (lane >> 3) + 8 * j; const LAS float* s = scr + (8 * c) * 33 + n;
        v4u o; o.x = pk2(s[0 * 33], s[1 * 33]); o.y = pk2(s[2 * 33], s[3 * 33]); o.z = pk2(s[4 * 33], s[5 * 33]); o.w = pk2(s[6 * 33], s[7 * 33]);
        *(GAS v4u*)(WT + (size_t)(r0 + n) * K + k0 + 8 * c) = o; }
    LDS_WAIT(); asm volatile("" ::: "memory");
}
__device__ __forceinline__ bool p0_matrix(int& r, const float* W, int K, int ldn, int ncols, bf16* WT, int swiglu, LAS float* scr, int lane) {
    const int ncb = ncols / 32, nit = (K / 64) * ncb;
    if (r >= nit) { r -= nit; return false; }
    const int kb = r / ncb, cb = r % ncb, c0 = 32 * cb;
    int r0 = c0;
    if (swiglu) { const int isu = c0 >= DFF ? 1 : 0, j = c0 - isu * DFF; r0 = (j >> 7) * 256 + isu * 128 + (j & 127); }
    p0_transpose_item(W, K, ldn, c0, 64 * kb, WT, r0, scr, lane);
    return true;
}
__device__ __forceinline__ void p0_prologue(Frame& F) {
    const int gw = blockIdx.x * NWAVES + F.wave, NGW = F.G * NWAVES;
    {
        LAS float* csL = (LAS float*)(F.lds);
        LAS float* part = (LAS float*)(F.lds + 32768);
        for (int u = F.tid; u < 8 * 1024; u += NWAVES * 64) { const float c = F.in[I_C][u]; csL[u] = c / (1.0f + expf(-c)); }
        LDS_WAIT(); __syncthreads();
        float* MOD = (float*)(F.ws + WS_MOD);
        for (int it = blockIdx.x; it < 224; it += F.G) {
            const float* W; const float* bias; float* out; int N, n0;
            if (it < 192) { const int l = it / 96; N = 6144; n0 = 64 * (it % 96); W = F.in[I_MOD_W] + (size_t)l * 1024 * 6144; bias = F.in[I_MOD_B] + l * 6144; out = MOD + (size_t)l * 8 * 6144; }
            else { N = 2048; n0 = 64 * (it - 192); W = F.in[I_KV_MOD_W]; bias = F.in[I_KV_MOD_B]; out = MOD + (size_t)2 * 8 * 6144; }
            float acc[8];
#pragma unroll
            for (int b = 0; b < 8; ++b) acc[b] = 0.f;
            const int kbeg = 128 * F.wave;
#pragma unroll 8
            for (int k = 0; k < 128; ++k) { const float w = W[(size_t)(kbeg + k) * N + n0 + F.lane];
#pragma unroll
                for (int b = 0; b < 8; ++b) acc[b] += csL[b * 1024 + kbeg + k] * w; }
#pragma unroll
            for (int b = 0; b < 8; ++b) part[(F.wave * 8 + b) * 64 + F.lane] = acc[b];
            LDS_WAIT(); __syncthreads();
            { const int b = F.wave; float s = bias[n0 + F.lane];
#pragma unroll
              for (int w = 0; w < 8; ++w) s += part[(w * 8 + b) * 64 + F.lane];
              out[(size_t)b * N + n0 + F.lane] = s; }
            LDS_WAIT(); __syncthreads();
        }
        __syncthreads();
    }
    LAS float* scr = (LAS float*)(F.lds + RING_OFF + F.wave * 16384);
    constexpr int NITEMS = 16 * 96 + 16 * 32 + 16 * 64 + 16 * 32 + 16 * 32 + 2 * (16 * 176) + 2 * (44 * 32);
    for (int it = gw; it < NITEMS; it += NGW) {
        int r = it;
        if (p0_matrix(r, F.in[I_A_W_IN], 1024, M_IN, M_INP, (bf16*)(F.ws + WS_WA_IN), 0, scr, F.lane)) continue;
        if (p0_matrix(r, F.in[I_A_W_OUT], 1024, 1024, 1024, (bf16*)(F.ws + WS_WA_OUT), 0, scr, F.lane)) continue;
        if (p0_matrix(r, F.in[I_KV_W], 1024, KV_OUT, 2048, (bf16*)(F.ws + WS_WKV), 0, scr, F.lane)) continue;
        if (p0_matrix(r, F.in[I_B_W_Q], 1024, 1024, 1024, (bf16*)(F.ws + WS_WQ), 0, scr, F.lane)) continue;
        if (p0_matrix(r, F.in[I_B_W_OUT], 1024, 1024, 1024, (bf16*)(F.ws + WS_WBO), 0, scr, F.lane)) continue;
        if (p0_matrix(r, F.in[I_FFN_W_IN], 1024, 2 * DFF, 2 * DFF, (bf16*)(F.ws + WS_WFI), 1, scr, F.lane)) continue;
        if (p0_matrix(r, F.in[I_FFN_W_IN] + (size_t)1024 * 2 * DFF, 1024, 2 * DFF, 2 * DFF, (bf16*)(F.ws + WS_WFI + WFI_STRIDE), 1, scr, F.lane)) continue;
        if (p0_matrix(r, F.in[I_FFN_W_OUT], DFF, 1024, 1024, (bf16*)(F.ws + WS_WFO), 0, scr, F.lane)) continue;
        p0_matrix(r, F.in[I_FFN_W_OUT] + (size_t)DFF * 1024, DFF, 1024, 1024, (bf16*)(F.ws + WS_WFO + WFO_STRIDE), 0, scr, F.lane);
    }
    __syncthreads();
}

constexpr int ROWS_PER_WAVE = 16;
#ifndef USE_DD
#define USE_DD 1
#endif
static_assert(M == 256 * NWAVES * ROWS_PER_WAVE, "row phases assume a 256-workgroup grid");

__device__ __forceinline__ void ld_par(const float* p, int lane, f32x4 (&v)[4]) { ld_row_f32(p, lane, v); }

__device__ __forceinline__ void stage_gate_w(Frame& F, const float* W, int ldn, int c0, int ncol) {
    LAS float* T = (LAS float*)F.lds;
    for (int u = F.tid; u < ncol * 1024; u += NWAVES * 64) { const int k = u / ncol, c = u % ncol; T[c * 1024 + k] = W[(size_t)k * ldn + c0 + c]; }
    LDS_WAIT(); __syncthreads();
}
__device__ __forceinline__ float gate_dot(Frame& F, const f32x4 (&h)[4], int c) {
    const LAS f32x4* T = (const LAS f32x4*)(F.lds) + c * 256 + F.lane;
    float s = 0.f;
#pragma unroll
    for (int j = 0; j < 4; ++j) s += dot4(h[j], T[64 * j]);
    return s;
}

__device__ __forceinline__ void row_phase_A(Frame& F) {
    stage_gate_w(F, F.in[I_A_W_IN], M_IN, M_INP, 8);
    const int gw = blockIdx.x * NWAVES + F.wave, m0 = gw * ROWS_PER_WAVE, b = m0 / SEQ, lane = F.lane;
    const float* mod = (const float*)(F.ws + WS_MOD) + (size_t)b * 6144;
    f32x4 gs[4], sh[4];
    { f32x4 g[4], sc[4]; ld_par(F.in[I_MIX_PRE_G], lane, g); ld_par(mod + 1024, lane, sc); ld_par(mod, lane, sh);
#pragma unroll
      for (int j = 0; j < 4; ++j) gs[j] = g[j] * (sc[j] + 1.0f); }
    bf16* XN = (bf16*)(F.ws + WS_RA);
    float* IG = (float*)(F.ws + WS_IG); float* LFp = (float*)(F.ws + WS_LF);
    const float gb = F.in[I_A_GATE_B][lane & 7];
    for (int i = 0; i < ROWS_PER_WAVE; ++i) {
        const int m = m0 + i, s = m - b * SEQ;
        f32x4 v[4]; ld_row_f32(F.in[I_X] + (size_t)m * D, lane, v);
        const float r = 1.0f / sqrtf(row_sumsq(v) * (1.0f / D) + EPS);
#pragma unroll
        for (int j = 0; j < 4; ++j) v[j] = v[j] * r * gs[j] + sh[j];
        st_row_bf16(XN + (size_t)m * D, lane, v);
        float mine = 0.f;
#pragma unroll 1
        for (int c = 0; c < 8; ++c) { const float t = wave_sum(gate_dot(F, v, c)); if (lane == c) mine = t; }
        if (lane < 8) { const float a = softcapf(mine + gb);
            if (lane < 4) IG[(size_t)(b * MH + lane) * SEQ + s] = a; else LFp[(size_t)(b * MH + lane - 4) * SEQ + s] = logsigf(a); }
    }
    __syncthreads();
}
__device__ __forceinline__ void row_phase_B(Frame& F) {
    const int gw = blockIdx.x * NWAVES + F.wave, m0 = gw * ROWS_PER_WAVE, b = m0 / SEQ, lane = F.lane;
    f32x4 hg[4]; ld_par(F.in[I_A_HNORM_G], lane, hg);
    const bf16* HH = (const bf16*)(F.ws + WS_RB); const bf16* PROJ = (const bf16*)(F.ws + WS_RP); bf16* Y = (bf16*)(F.ws + WS_RA);
    const float* DD = (const float*)(F.ws + WS_F2);
    for (int i = 0; i < ROWS_PER_WAVE; ++i) {
        const int m = m0 + i, s = m - b * SEQ;
        f32x4 v[4], o[4]; ld_row_bf16(HH + (size_t)m * D, lane, v); ld_row_bf16(PROJ + (size_t)m * M_INP + 2048, lane, o);
#pragma unroll
        for (int j = 0; j < 4; ++j) { const float dd = USE_DD ? DD[(size_t)(b * MH + j) * SEQ + s] : 1.0f;
            const float r = 1.0f / sqrtf(wave_sum(dot4(v[j], v[j])) * (1.0f / MV) + EPS * dd * dd);
            f32x4 sg; sg.x = 1.0f / (1.0f + expf(-o[j].x)); sg.y = 1.0f / (1.0f + expf(-o[j].y)); sg.z = 1.0f / (1.0f + expf(-o[j].z)); sg.w = 1.0f / (1.0f + expf(-o[j].w));
            v[j] = sg * (v[j] * r * hg[j]); }
        st_row_bf16(Y + (size_t)m * D, lane, v);
    }
}
template <int MODE, int XSRC  >
__device__ __forceinline__ void row_phase_C(Frame& F, const float* x_old, const float* post_g, const float* gate_base  ,
                                            const float* pre_g, const float* scsh_base  ) {
    if (MODE == 1) stage_gate_w(F, F.in[I_KV_W], KV_OUT, 2048, 16);
    const int gw = blockIdx.x * NWAVES + F.wave, m0 = gw * ROWS_PER_WAVE, b = m0 / SEQ, lane = F.lane;
    f32x4 gp[4];
    { f32x4 pg[4], gt[4]; ld_par(post_g, lane, pg); ld_par(gate_base + (size_t)b * 6144, lane, gt);
#pragma unroll
      for (int j = 0; j < 4; ++j) gp[j] = pg[j] * gt[j]; }
    f32x4 gs[4], sh[4], gs2[4], sh2[4];
    if (MODE != 2) { f32x4 g[4], sc[4]; ld_par(pre_g, lane, g); ld_par(scsh_base + (size_t)b * 6144 + 1024, lane, sc); ld_par(scsh_base + (size_t)b * 6144, lane, sh);
#pragma unroll
      for (int j = 0; j < 4; ++j) gs[j] = g[j] * (sc[j] + 1.0f); }
    if (MODE == 1) { const float* kvm = (const float*)(F.ws + WS_MOD) + (size_t)2 * 8 * 6144 + (size_t)b * 2048;
      f32x4 g[4], sc[4]; ld_par(F.in[I_KV_NORM_G], lane, g); ld_par(kvm + 1024, lane, sc); ld_par(kvm, lane, sh2);
#pragma unroll
      for (int j = 0; j < 4; ++j) gs2[j] = g[j] * (sc[j] + 1.0f); }
    const bf16* Z = (const bf16*)(F.ws + WS_RD); bf16* XN = (bf16*)(F.ws + WS_RA); bf16* XN2 = (bf16*)(F.ws + WS_RB);
    float* LOGF = (float*)(F.ws + WS_LOGF); bf16* XR = (bf16*)(F.ws + WS_RX);
    const float fb = (MODE == 1) ? F.in[I_KV_FGATE_B][lane & 15] : 0.f;
    for (int i = 0; i < ROWS_PER_WAVE; ++i) {
        const int m = m0 + i, s = m - b * SEQ;
        f32x4 z[4], x[4]; ld_row_bf16(Z + (size_t)m * D, lane, z);
        if (XSRC == 0) ld_row_f32(x_old + (size_t)m * D, lane, x); else ld_row_bf16(XR + (size_t)m * D, lane, x);
        const float rz = 1.0f / sqrtf(row_sumsq(z) * (1.0f / D) + EPS);
#pragma unroll
        for (int j = 0; j < 4; ++j) x[j] = x[j] + gp[j] * (z[j] * rz);
        if (MODE == 2) st_row_f32(F.out + (size_t)m * D, lane, x); else st_row_bf16(XR + (size_t)m * D, lane, x);
        if (MODE != 2) {
            const float r = 1.0f / sqrtf(row_sumsq(x) * (1.0f / D) + EPS);
            f32x4 h[4];
#pragma unroll
            for (int j = 0; j < 4; ++j) h[j] = x[j] * r * gs[j] + sh[j];
            st_row_bf16(XN + (size_t)m * D, lane, h);
            if (MODE == 1) {
#pragma unroll
                for (int j = 0; j < 4; ++j) h[j] = x[j] * r * gs2[j] + sh2[j];
                st_row_bf16(XN2 + (size_t)m * D, lane, h);
                float mine = 0.f;
#pragma unroll 1
                for (int c = 0; c < 16; ++c) { const float t = wave_sum(gate_dot(F, h, c)); if (lane == c) mine = t; }
                if (lane < 16) LOGF[(size_t)(b * FH + lane) * SEQ + s] = logsigf(mine + fb);
            }
        }
    }
    if (MODE == 1) __syncthreads();
}
__device__ __forceinline__ void cumsum_f2(Frame& F) {
    const int gw = blockIdx.x * NWAVES + F.wave;
    if (gw >= BATCH * FH) return;
    const float* src = (const float*)(F.ws + WS_LOGF) + (size_t)gw * SEQ + 64 * F.lane; float* dst = (float*)(F.ws + WS_F2) + (size_t)gw * SEQ + 64 * F.lane;
    float tot = 0.f;
    for (int i = 0; i < 16; ++i) { const f32x4 v = *(const gf32x4*)(src + 4 * i); tot += (v.x + v.y) + (v.z + v.w); }
    float incl = tot;
#pragma unroll
    for (int o = 1; o < 64; o <<= 1) { const float t = __shfl_up(incl, o); if (F.lane >= o) incl += t; }
    float run = incl - tot;
    for (int i = 0; i < 16; ++i) { const f32x4 v = *(const gf32x4*)(src + 4 * i); f32x4 o;
        run += v.x; o.x = run * LOG2E; run += v.y; o.y = run * LOG2E; run += v.z; o.z = run * LOG2E; run += v.w; o.w = run * LOG2E;
        *(gf32x4*)(dst + 4 * i) = o; }
}

__device__ __forceinline__ void mlstm_naive(Frame& F) {
    LAS float* qs = (LAS float*)(F.lds);
    LAS float* ks = qs + 32 * 128;
    LAS float* vs = ks + 32 * 128;
    LAS float* nums = vs + 32 * 256;
    LAS float* gts = nums + 32 * 257;
    LAS float* ems = gts + 96;
    const bf16* PROJ = (const bf16*)(F.ws + WS_RP); bf16* HH = (bf16*)(F.ws + WS_RB);
    const float* IG = (const float*)(F.ws + WS_IG); const float* LFp = (const float*)(F.ws + WS_LF);
    const float qscale = 0.08838834764831845f;
    for (int bh = blockIdx.x; bh < BATCH * MH; bh += F.G) {
        const int b = bh / MH, h = bh % MH;
        float C[128];
#pragma unroll
        for (int k = 0; k < 128; ++k) C[k] = 0.f;
        float mrun = 0.f;
        for (int s0 = 0; s0 < SEQ; s0 += 32) {
            __syncthreads();
            for (int u = F.tid; u < 32 * 128; u += NWAVES * 64) { const int t = u >> 7, k = u & 127; const bf16* row = PROJ + (size_t)(b * SEQ + s0 + t) * M_INP;
                qs[u] = bf2f(row[h * MQK + k]) * qscale; ks[u] = bf2f(row[512 + h * MQK + k]); }
            for (int u = F.tid; u < 32 * 256; u += NWAVES * 64) { const int t = u >> 8, c = u & 255; vs[u] = bf2f(PROJ[(size_t)(b * SEQ + s0 + t) * M_INP + 1024 + h * MV + c]); }
            if (F.tid < 32) { gts[F.tid] = IG[(size_t)bh * SEQ + s0 + F.tid]; gts[32 + F.tid] = LFp[(size_t)bh * SEQ + s0 + F.tid]; }
            LDS_WAIT(); __syncthreads();
            if (F.tid <= 256) {
                for (int t = 0; t < 32; ++t) {
                    const float ig = gts[t], lf = gts[32 + t];
                    const float mn = fmaxf(lf + mrun, ig), fd = expf(lf + mrun - mn), ie = expf(ig - mn); mrun = mn;
                    const float sv = ie * (F.tid < 256 ? vs[t * 256 + F.tid] : 1.0f);
                    float num = 0.f;
                    const LAS f32x4* q4 = (const LAS f32x4*)(qs + t * 128); const LAS f32x4* k4 = (const LAS f32x4*)(ks + t * 128);
#pragma unroll
                    for (int k = 0; k < 32; ++k) { const f32x4 qq = q4[k], kk = k4[k];
                        C[4 * k + 0] = fd * C[4 * k + 0] + sv * kk.x; num += qq.x * C[4 * k + 0];
                        C[4 * k + 1] = fd * C[4 * k + 1] + sv * kk.y; num += qq.y * C[4 * k + 1];
                        C[4 * k + 2] = fd * C[4 * k + 2] + sv * kk.z; num += qq.z * C[4 * k + 2];
                        C[4 * k + 3] = fd * C[4 * k + 3] + sv * kk.w; num += qq.w * C[4 * k + 3]; }
                    nums[t * 257 + F.tid] = num;
                    if (F.tid == 256) ems[t] = expf(-mn);
                }
            }
            LDS_WAIT(); __syncthreads();
            for (int u = F.tid; u < 32 * 256; u += NWAVES * 64) { const int t = u >> 8, c = u & 255;
                const float den = fmaxf(fabsf(nums[t * 257 + 256]), ems[t]);
                HH[(size_t)(b * SEQ + s0 + t) * D + h * MV + c] = (bf16)f2bf(nums[t * 257 + c] / den); }
        }
        __syncthreads();
    }
}

__device__ __forceinline__ void attn_naive(Frame& F) {
    LAS float* Ks = (LAS float*)(F.lds);
    LAS float* Vs = Ks + 64 * 64;
    LAS float* Fs = Vs + 64 * 64;
    const bf16* Q = (const bf16*)(F.ws + WS_RP); const bf16* K = Q + (size_t)M * D; const bf16* V = K + (size_t)M * D; bf16* O = (bf16*)(F.ws + WS_RP);
    const float* F2 = (const float*)(F.ws + WS_F2);
    for (int u = blockIdx.x; u < BATCH * FH * (SEQ / 512); u += F.G) {
        const int bh = u / (SEQ / 512), qb = u % (SEQ / 512), b = bh / FH, h = bh % FH;
        const int t = qb * 512 + F.tid; const size_t rowq = (size_t)(b * SEQ + t) * D + h * FHD;
        float q[64], o[64];
#pragma unroll
        for (int d = 0; d < 64; ++d) { q[d] = bf2f(Q[rowq + d]); o[d] = 0.f; }
        const float ft = F2[(size_t)bh * SEQ + t];
        float mrun = -1e30f, l = 0.f;
        const int ntile = (qb * 512 + 512) / 64;
        for (int kt = 0; kt < ntile; ++kt) {
            __syncthreads();
            for (int e = F.tid; e < 64 * 64; e += NWAVES * 64) { const int j = e >> 6, d = e & 63; const size_t a = (size_t)(b * SEQ + kt * 64 + j) * D + h * FHD + d; Ks[e] = bf2f(K[a]); Vs[e] = bf2f(V[a]); }
            if (F.tid < 64) Fs[F.tid] = F2[(size_t)bh * SEQ + kt * 64 + F.tid];
            LDS_WAIT(); __syncthreads();
            for (int j = 0; j < 64; ++j) {
                if (kt * 64 + j <= t) {
                    float x = 0.f; const LAS f32x4* k4 = (const LAS f32x4*)(Ks + j * 64);
#pragma unroll
                    for (int d = 0; d < 16; ++d) { const f32x4 kk = k4[d]; x += q[4 * d] * kk.x + q[4 * d + 1] * kk.y + q[4 * d + 2] * kk.z + q[4 * d + 3] * kk.w; }
                    x += ft - Fs[j];
                    const float mn = fmaxf(mrun, x), al = exp2f(mrun - mn), p = exp2f(x - mn); mrun = mn; l = l * al + p;
                    const LAS f32x4* v4 = (const LAS f32x4*)(Vs + j * 64);
#pragma unroll
                    for (int d = 0; d < 16; ++d) { const f32x4 vv = v4[d]; o[4 * d] = o[4 * d] * al + p * vv.x; o[4 * d + 1] = o[4 * d + 1] * al + p * vv.y; o[4 * d + 2] = o[4 * d + 2] * al + p * vv.z; o[4 * d + 3] = o[4 * d + 3] * al + p * vv.w; }
                }
            }
        }
        const float rl = 1.0f / l;
#pragma unroll
        for (int d = 0; d < 64; ++d) O[rowq + d] = (bf16)f2bf(o[d] * rl);
        __syncthreads();
    }
}

namespace fa {
typedef short bf16x8 __attribute__((ext_vector_type(8)));
typedef short s16x4 __attribute__((ext_vector_type(4)));
typedef float f32x16 __attribute__((ext_vector_type(16)));
typedef unsigned u32x4 __attribute__((ext_vector_type(4)));
typedef float f32x4v __attribute__((ext_vector_type(4)));
typedef float f32x2_t __attribute__((ext_vector_type(2))); typedef __bf16 bf16x2_t __attribute__((ext_vector_type(2)));
constexpr int DM = 1024, QB = 256, KVBLK = 64, SLOTB = 8192;
constexpr int NSLOT = 4;
constexpr int L_K = 0, L_V = NSLOT * SLOTB, L_WS = 2 * NSLOT * SLOTB, L_OST = L_WS + 8 * 64 * 4, L_F = L_OST + 8 * 4096, L_TB = L_F + 4096 * 4, L_END = L_TB + 64;
static_assert(L_END <= 131072, "attention LDS map");
constexpr float NEG = -1.0e30f;
__device__ __forceinline__ int crow(int r, int hi) { return (r & 3) + 8 * (r >> 2) + 4 * hi; }
__device__ __forceinline__ unsigned cvtpk(float lo, float hi) { f32x2_t v = {lo, hi}; bf16x2_t b = __builtin_convertvector(v, bf16x2_t); return __builtin_bit_cast(unsigned, b); }
__device__ __forceinline__ void glds16(const void* gsrc, unsigned lds_dst) { unsigned keep;
    asm volatile("s_mov_b32 %0, m0\n\ts_mov_b32 m0, %2\n\ts_nop 0\n\tglobal_load_lds_dwordx4 %1, off\n\ts_mov_b32 m0, %0" : "=&s"(keep) : "v"(gsrc), "s"(lds_dst) : "memory"); }

__device__ __forceinline__ void qkt(f32x16& p0, f32x16& p1, const LAS char* Kslot, const bf16x8 (&qr)[4], int r32, int hi) {
    const LAS char* kb = Kslot + hi * 1024 + r32 * 16;
    const f32x16 z = {};
#pragma unroll
    for (int d0 = 0; d0 < 4; ++d0) {
        const bf16x8 b0 = *(const LAS bf16x8*)(kb + d0 * 2048);
        const bf16x8 b1 = *(const LAS bf16x8*)(kb + d0 * 2048 + 512);
        if (d0 == 0) { p0 = __builtin_amdgcn_mfma_f32_32x32x16_bf16(b0, qr[0], z, 0, 0, 0); p1 = __builtin_amdgcn_mfma_f32_32x32x16_bf16(b1, qr[0], z, 0, 0, 0); }
        else { p0 = __builtin_amdgcn_mfma_f32_32x32x16_bf16(b0, qr[d0], p0, 0, 0, 0); p1 = __builtin_amdgcn_mfma_f32_32x32x16_bf16(b1, qr[d0], p1, 0, 0, 0); }
    }
}
__device__ __forceinline__ void pv(f32x16 (&o)[2], int vb, bf16x8 pa0, bf16x8 pa1, bf16x8 pa2, bf16x8 pa3) {
#pragma unroll
    for (int d0 = 0; d0 < 2; ++d0) { s16x4 lo[4], hi[4];
#pragma unroll
        for (int ks = 0; ks < 4; ++ks) {
            asm volatile("ds_read_b64_tr_b16 %0,%1 offset:%c2" : "=&v"(lo[ks]) : "v"(vb), "i"(d0 * 4096 + ks * 1024) : "memory");
            asm volatile("ds_read_b64_tr_b16 %0,%1 offset:%c2" : "=&v"(hi[ks]) : "v"(vb), "i"(d0 * 4096 + ks * 1024 + 512) : "memory"); }
        asm volatile("s_waitcnt lgkmcnt(0)" ::: "memory"); __builtin_amdgcn_sched_barrier(0);
#define FA_PK(k) (bf16x8){lo[k][0], lo[k][1], lo[k][2], lo[k][3], hi[k][0], hi[k][1], hi[k][2], hi[k][3]}
        o[d0] = __builtin_amdgcn_mfma_f32_32x32x16_bf16(pa0, FA_PK(0), o[d0], 0, 0, 0);
        o[d0] = __builtin_amdgcn_mfma_f32_32x32x16_bf16(pa1, FA_PK(1), o[d0], 0, 0, 0);
        o[d0] = __builtin_amdgcn_mfma_f32_32x32x16_bf16(pa2, FA_PK(2), o[d0], 0, 0, 0);
        o[d0] = __builtin_amdgcn_mfma_f32_32x32x16_bf16(pa3, FA_PK(3), o[d0], 0, 0, 0);
#undef FA_PK
    }
}
__device__ __forceinline__ float rowmax32(const f32x16& p0, const f32x16& p1) {
    float a = __builtin_fmaxf(p0[0], p1[0]), b = __builtin_fmaxf(p0[1], p1[1]);
#pragma unroll
    for (int r = 2; r < 16; r += 2) { a = __builtin_fmaxf(a, __builtin_fmaxf(p0[r], p1[r])); b = __builtin_fmaxf(b, __builtin_fmaxf(p0[r + 1], p1[r + 1])); }
    float m = __builtin_fmaxf(a, b);
    auto rr = __builtin_amdgcn_permlane32_swap(__float_as_uint(m), __float_as_uint(m), false, false);
    return __builtin_fmaxf(__uint_as_float(rr[0]), __uint_as_float(rr[1]));
}

__device__ __forceinline__ int first_tile(const float* F2row, int qb, float qk2, int lane) {
    const int NT = (qb * QB + QB) / KVBLK, jmax = NT - 4;
    const float fref = F2row[qb * QB];
    const int j = lane < jmax ? lane : jmax;
    const bool live = (lane >= jmax) || (fref - F2row[j * KVBLK + KVBLK - 1] + qk2 >= -160.0f);
    const unsigned long long bal = __ballot(live);
    return (int)__builtin_ctzll(bal);
}
template <bool SKIP>
__device__ __forceinline__ void attn_unit(int b, int h, int qb, int tb, const bf16* Q, const bf16* K, const bf16* V, bf16* O, const float* F2row, LAS unsigned char* shm) {
    const int tid = threadIdx.x, lane = tid & 63, r32 = lane & 31, hi = lane >> 5; const int wid = __builtin_amdgcn_readfirstlane(tid >> 6);
    const long rowbase = (long)b * SEQ; const int q0 = qb * QB;
    const bf16* Qw = Q + (rowbase + q0 + wid * 32) * DM + h * 64;
    const bf16* Kh = K + rowbase * DM + h * 64; const bf16* Vh = V + rowbase * DM + h * 64;
    const unsigned lds0 = (unsigned)(size_t)shm;
    LAS float* wsf = (LAS float*)(shm + L_WS) + wid * 64;
    LAS float* Fl = (LAS float*)(shm + L_F);
    const int NT = (q0 + QB) / KVBLK;
    if (!SKIP) tb = 0;
    const float fref = F2row[q0];
    bf16x8 qr[4];
#pragma unroll
    for (int d0 = 0; d0 < 4; ++d0) qr[d0] = *reinterpret_cast<const bf16x8*>(&Qw[(long)r32 * DM + d0 * 16 + hi * 8]);
    for (int i = tid; i < (NT - tb) * KVBLK; i += NWAVES * 64) Fl[i] = F2row[tb * KVBLK + i] - fref;
    asm volatile("s_waitcnt vmcnt(0)" : "+v"(qr[0]), "+v"(qr[1]), "+v"(qr[2]), "+v"(qr[3]) :: "memory");
    const bf16* ksrc = Kh + (long)lane * DM + wid * 8;
    const bf16* vsrc = Vh + (long)(16 * (wid & 3) + (lane >> 2)) * DM + (wid >> 2) * 32 + (lane & 3) * 8;
    const unsigned kdst = lds0 + L_K + wid * 1024, vdst = lds0 + L_V + wid * 1024;
#define FA_DMA(t, slot) do { glds16(ksrc + (long)(t) * KVBLK * DM, (unsigned)__builtin_amdgcn_readfirstlane(kdst + (slot) * SLOTB)); \
                             glds16(vsrc + (long)(t) * KVBLK * DM, (unsigned)__builtin_amdgcn_readfirstlane(vdst + (slot) * SLOTB)); } while (0)
    FA_DMA(tb, 0);
    if (tb + 1 < NT) FA_DMA(tb + 1, 1);
    if (tb + 2 < NT) FA_DMA(tb + 2, 2);
    const int vb0 = (int)(lds0 + L_V) + ((lane >> 4) & 1) * 32 + (lane & 3) * 8 + (4 * hi + ((lane & 15) >> 2)) * 64;
    const int qrel = wid * 32 + r32;
    float mrow = NEG, l_reg = 0.f; f32x16 o[2]; o[0] = f32x16{}; o[1] = f32x16{};
    for (int t = tb; t < NT; ++t) {
        const int cur = (t - tb) & 3;
        if (t + 2 < NT) asm volatile("s_waitcnt vmcnt(4) lgkmcnt(0)\n\ts_barrier" ::: "memory");
        else if (t + 1 < NT) asm volatile("s_waitcnt vmcnt(2) lgkmcnt(0)\n\ts_barrier" ::: "memory");
        else asm volatile("s_waitcnt vmcnt(0) lgkmcnt(0)\n\ts_barrier" ::: "memory");
        if (t + 3 < NT) FA_DMA(t + 3, (cur + 3) & 3);
        f32x16 p0, p1;
        qkt(p0, p1, (const LAS char*)(shm + L_K + cur * SLOTB), qr, r32, hi);
        { const LAS f32x4v* F4 = (const LAS f32x4v*)(Fl + (t - tb) * KVBLK);
#pragma unroll
          for (int g = 0; g < 4; ++g) { const f32x4v b0 = F4[2 * g + hi], b1 = F4[8 + 2 * g + hi];
#pragma unroll
              for (int e = 0; e < 4; ++e) { p0[4 * g + e] -= b0[e]; p1[4 * g + e] -= b1[e]; } } }
        if (t >= NT - 4) { const int kb = 64 * (t - (NT - 4)) + 4 * hi;
#pragma unroll
            for (int r = 0; r < 16; ++r) { const int kv = kb + (r & 3) + 8 * (r >> 2); if (kv > qrel) p0[r] = NEG; if (kv + 32 > qrel) p1[r] = NEG; } }
        const float rm = rowmax32(p0, p1);
        const float mn = __builtin_fmaxf(mrow, rm), alpha = __builtin_amdgcn_exp2f(mrow - mn);
        float sacc = 0.f;
#pragma unroll
        for (int r = 0; r < 16; ++r) { p0[r] = __builtin_amdgcn_exp2f(p0[r] - mn); p1[r] = __builtin_amdgcn_exp2f(p1[r] - mn); sacc += p0[r] + p1[r]; }
        l_reg = l_reg * alpha + sacc;
        if (__any(mn > mrow)) {
            if (hi == 0) wsf[r32] = alpha;
            asm volatile("s_waitcnt lgkmcnt(0)" ::: "memory");
#pragma unroll
            for (int r = 0; r < 16; ++r) { const float f = wsf[crow(r, hi)]; o[0][r] *= f; o[1][r] *= f; }
            asm volatile("s_waitcnt lgkmcnt(0)" ::: "memory");
        }
        mrow = mn;
        u32x4 pw0, pw1, pw2, pw3;
        pw0 = (u32x4){cvtpk(p0[0], p0[1]), cvtpk(p0[2], p0[3]), cvtpk(p0[4], p0[5]), cvtpk(p0[6], p0[7])};
        pw1 = (u32x4){cvtpk(p0[8], p0[9]), cvtpk(p0[10], p0[11]), cvtpk(p0[12], p0[13]), cvtpk(p0[14], p0[15])};
        pw2 = (u32x4){cvtpk(p1[0], p1[1]), cvtpk(p1[2], p1[3]), cvtpk(p1[4], p1[5]), cvtpk(p1[6], p1[7])};
        pw3 = (u32x4){cvtpk(p1[8], p1[9]), cvtpk(p1[10], p1[11]), cvtpk(p1[12], p1[13]), cvtpk(p1[14], p1[15])};
        pv(o, vb0 + cur * SLOTB, __builtin_bit_cast(bf16x8, pw0), __builtin_bit_cast(bf16x8, pw1), __builtin_bit_cast(bf16x8, pw2), __builtin_bit_cast(bf16x8, pw3));
    }
#undef FA_DMA
    { auto rr = __builtin_amdgcn_permlane32_swap(__float_as_uint(l_reg), __float_as_uint(l_reg), false, false); l_reg = __uint_as_float(rr[0]) + __uint_as_float(rr[1]); }
    if (hi == 0) wsf[32 + r32] = l_reg;
    asm volatile("s_waitcnt lgkmcnt(0)" ::: "memory");
    float rli[16];
#pragma unroll
    for (int r = 0; r < 16; ++r) rli[r] = __builtin_amdgcn_rcpf(wsf[32 + crow(r, hi)]);
    bf16* Ow = O + (rowbase + q0 + wid * 32) * DM + h * 64;
    { LAS bf16* stg = (LAS bf16*)(shm + L_OST) + wid * 2048;
#pragma unroll
      for (int r = 0; r < 16; ++r) { const int orow = crow(r, hi);
#pragma unroll
          for (int d0 = 0; d0 < 2; ++d0) stg[orow * 64 + d0 * 32 + r32] = (bf16)f2bf(o[d0][r] * rli[r]); }
      asm volatile("s_waitcnt lgkmcnt(0)" ::: "memory");
#pragma unroll
      for (int i = 0; i < 4; ++i) { const int row = i * 8 + (lane >> 3), ch = lane & 7; const u32x4 v = *(const LAS u32x4*)(stg + row * 64 + ch * 8); *(u32x4*)(Ow + (long)row * DM + ch * 8) = v; } }
    asm volatile("s_waitcnt lgkmcnt(0)" ::: "memory"); __syncthreads();
}
}

template <bool SKIP>
__device__ __forceinline__ void attn_phase(Frame& F) {
    const bf16* Q = (const bf16*)(F.ws + WS_RP); const bf16* K = Q + (size_t)M * D; const bf16* V = K + (size_t)M * D; bf16* O = (bf16*)(F.ws + WS_RB);
    const int bx = blockIdx.x, vcu = (bx % 8) * (F.G / 8) + bx / 8;
    const int bh = vcu >> 1, half = vcu & 1, b = bh / FH, h = bh % FH;
    const float* F2row = (const float*)(F.ws + WS_F2) + (size_t)bh * SEQ;
    float qk2 = 0.f;
    if (SKIP) { const gu32* nb = F.ctl + CW_NORM + 4 * bh;
        const float qn2 = __uint_as_float(__hip_atomic_load(nb + 0, RLX_AGENT)) + __uint_as_float(__hip_atomic_load(nb + 1, RLX_AGENT));
        const float kn2 = __uint_as_float(__hip_atomic_load(nb + 2, RLX_AGENT)) + __uint_as_float(__hip_atomic_load(nb + 3, RLX_AGENT));
        qk2 = 2.0f * sqrtf(qn2 * kn2) * 1.01f + 1.0f; }
    LAS int* tbs = (LAS int*)(F.lds + fa::L_TB);
    if (SKIP) { const int i = F.wave, base = 2 * (i >> 1) + half, qb = (i & 1) ? 15 - base : base;
        const int tb = fa::first_tile(F2row, qb, qk2, F.lane); if (F.lane == 0) tbs[i] = tb; }
    LDS_WAIT(); __syncthreads();
    for (int i = 0; i < 8; ++i) {
        const int base = 2 * (i >> 1) + half, qb = (i & 1) ? 15 - base : base;
        const int tb = SKIP ? __builtin_amdgcn_readfirstlane(tbs[i]) : 0;
        fa::attn_unit<SKIP>(b, h, qb, tb, Q, K, V, O, F2row, F.lds);
    }
}

namespace fw {
using fa::bf16x8; using fa::s16x4; using fa::f32x16; using fa::u32x4; using fa::f32x4v; using fa::crow; using fa::cvtpk; using fa::glds16; using fa::NEG;
constexpr int DM = 1024, WREG = 17408;
constexpr int W_K = 0, W_V = 8192, W_F = 16384, W_WS = 16896, W_TB = 17152;
static_assert(8 * WREG <= RING_BYTES, "attention LDS map");
__device__ __forceinline__ void glds4(const void* gsrc, unsigned lds_dst) { unsigned keep;
    asm volatile("s_mov_b32 %0, m0\n\ts_mov_b32 m0, %2\n\ts_nop 0\n\tglobal_load_lds_dword %1, off\n\ts_mov_b32 m0, %0" : "=&s"(keep) : "v"(gsrc), "s"(lds_dst) : "memory"); }

template <bool SKIP>
__device__ __forceinline__ void attn_phase(Frame& F) {
    const int lane = F.lane, r32 = lane & 31, hi = lane >> 5, wid = F.wave;
    const bf16* Q = (const bf16*)(F.ws + WS_RP); const bf16* K = Q + (size_t)M * D; const bf16* V = K + (size_t)M * D; bf16* O = (bf16*)(F.ws + WS_RB);
    const float* F2 = (const float*)(F.ws + WS_F2);
    const int bx = blockIdx.x, vcu = (bx % 8) * (F.G / 8) + bx / 8, gw = vcu * NWAVES + wid;
    LAS unsigned char* wl = F.lds + wid * WREG;
    const unsigned lw = (unsigned)(size_t)wl;
    LAS float* wsf = (LAS float*)(wl + W_WS);
    LAS int* tbs = (LAS int*)(wl + W_TB);
#define FW_BH(i) ((2048 * (i) + gw) >> 7)
#define FW_U(i) (((i) & 1) ? 127 - ((2048 * (i) + gw) & 127) : ((2048 * (i) + gw) & 127))
    for (int i = 0; i < 8; ++i) {
        const int u = FW_U(i), bh = FW_BH(i); int jf = 0;
        if (SKIP) { const float* F2row = F2 + (size_t)bh * SEQ; const gu32* nb = F.ctl + CW_NORM + 4 * bh;
            const float qn2 = __uint_as_float(__hip_atomic_load(nb + 0, RLX_AGENT)) + __uint_as_float(__hip_atomic_load(nb + 1, RLX_AGENT));
            const float kn2 = __uint_as_float(__hip_atomic_load(nb + 2, RLX_AGENT)) + __uint_as_float(__hip_atomic_load(nb + 3, RLX_AGENT));
            const float qk2 = 2.0f * sqrtf(qn2 * kn2) * 1.01f + 1.0f;
            const float fr_ = F2row[32 * u];
            const int j0 = lane < u ? lane : u, j1 = lane + 64 < u ? lane + 64 : u;
            const bool l0 = (lane >= u) || (fr_ - F2row[32 * j0 + 31] + qk2 >= -160.0f);
            const bool l1 = (lane + 64 >= u) || (fr_ - F2row[32 * j1 + 31] + qk2 >= -160.0f);
            const unsigned long long b0 = __ballot(l0), b1 = __ballot(l1);
            jf = b0 ? (int)__builtin_ctzll(b0) : 64 + (int)__builtin_ctzll(b1); }
        if (lane == 0) tbs[i] = jf;
    }
    asm volatile("s_waitcnt lgkmcnt(0)" ::: "memory");
    const long klane = (long)(lane & 31) * DM + (lane >> 5) * 8, vlane = (long)(lane >> 2) * DM + (lane & 3) * 8;
#define FW_DMA(kp, vp, fp, j, slot) do { const long ro_ = (long)(j) * 32 * DM; \
        _Pragma("unroll") for (int i_ = 0; i_ < 4; ++i_) glds16((kp) + ro_ + i_ * 16, (unsigned)__builtin_amdgcn_readfirstlane(lw + W_K + (slot) * 4096 + i_ * 1024)); \
        _Pragma("unroll") for (int i_ = 0; i_ < 4; ++i_) glds16((vp) + ro_ + (long)(16 * (i_ & 1)) * DM + (i_ >> 1) * 32, (unsigned)__builtin_amdgcn_readfirstlane(lw + W_V + (slot) * 4096 + i_ * 1024)); \
        glds4((fp) + (j) * 32 + lane, (unsigned)__builtin_amdgcn_readfirstlane(lw + W_F + (slot) * 256)); } while (0)
#define FW_PTRS(bh_, kp, vp, fp, rb) const int b_##kp = (bh_) / FH, h_##kp = (bh_) % FH; const long rb = (long)b_##kp * SEQ; \
        const bf16* kp = K + rb * DM + h_##kp * 64 + klane; const bf16* vp = V + rb * DM + h_##kp * 64 + vlane; const float* fp = F2 + (size_t)(bh_) * SEQ
    const int vbo = ((lane >> 4) & 1) * 32 + (lane & 3) * 8 + (4 * hi + ((lane & 15) >> 2)) * 64;
    int slot = 0;
    int u = FW_U(0), bh = FW_BH(0), jf = __builtin_amdgcn_readfirstlane(tbs[0]);
    bf16x8 qr[4]; float fref;
    { FW_PTRS(bh, kp0, vp0, fp0, rb0);
      const bf16* Qw = Q + (rb0 + 32 * u) * DM + (bh % FH) * 64;
#pragma unroll
      for (int d0 = 0; d0 < 4; ++d0) qr[d0] = *reinterpret_cast<const bf16x8*>(&Qw[(long)r32 * DM + d0 * 16 + hi * 8]);
      fref = fp0[32 * u];
      FW_DMA(kp0, vp0, fp0, jf, 0); }
    for (int i = 0; i < 8; ++i) {
        const int un = (i + 1 < 8) ? FW_U(i + 1) : 0, bhn = (i + 1 < 8) ? FW_BH(i + 1) : 0; const int jfn = (i + 1 < 8) ? __builtin_amdgcn_readfirstlane(tbs[(i + 1) & 7]) : 0;
        FW_PTRS(bh, kpc, vpc, fpc, rbc);
        bf16x8 qn[4]; float frefn = 0.f;
        float mrow = NEG, l_reg = 0.f; f32x16 o[2]; o[0] = f32x16{}; o[1] = f32x16{};
        for (int t = jf; t <= u; ++t) {
            asm volatile("s_waitcnt vmcnt(0)" : "+v"(qr[0]), "+v"(qr[1]), "+v"(qr[2]), "+v"(qr[3]), "+v"(fref) :: "memory");
            if (t < u) { FW_DMA(kpc, vpc, fpc, t + 1, slot ^ 1); }
            else if (i + 1 < 8) { FW_PTRS(bhn, kpn, vpn, fpn, rbn); FW_DMA(kpn, vpn, fpn, jfn, slot ^ 1);
                const bf16* Qw = Q + (rbn + 32 * un) * DM + (bhn % FH) * 64;
#pragma unroll
                for (int d0 = 0; d0 < 4; ++d0) qn[d0] = *reinterpret_cast<const bf16x8*>(&Qw[(long)r32 * DM + d0 * 16 + hi * 8]);
                frefn = fpn[32 * un]; }
            f32x16 p;
#pragma unroll
            for (int r = 0; r < 16; ++r) p[r] = fref;
            { const LAS unsigned char* kb = wl + W_K + slot * 4096 + hi * 512 + r32 * 16;
#pragma unroll
              for (int d0 = 0; d0 < 4; ++d0) { const bf16x8 kf = *(const LAS bf16x8*)(kb + d0 * 1024); p = __builtin_amdgcn_mfma_f32_32x32x16_bf16(kf, qr[d0], p, 0, 0, 0); } }
            { const LAS f32x4v* F4 = (const LAS f32x4v*)(wl + W_F + slot * 256);
#pragma unroll
              for (int g = 0; g < 4; ++g) { const f32x4v bv = F4[2 * g + hi];
#pragma unroll
                  for (int e = 0; e < 4; ++e) p[4 * g + e] -= bv[e]; } }
            if (t == u) {
#pragma unroll
                for (int r = 0; r < 16; ++r) if (crow(r, hi) > r32) p[r] = NEG; }
            float rm;
            { float a = __builtin_fmaxf(p[0], p[1]), c = __builtin_fmaxf(p[2], p[3]);
#pragma unroll
              for (int r = 4; r < 16; r += 4) { a = __builtin_fmaxf(a, __builtin_fmaxf(p[r], p[r + 1])); c = __builtin_fmaxf(c, __builtin_fmaxf(p[r + 2], p[r + 3])); }
              rm = __builtin_fmaxf(a, c);
              auto rr = __builtin_amdgcn_permlane32_swap(__float_as_uint(rm), __float_as_uint(rm), false, false);
              rm = __builtin_fmaxf(__uint_as_float(rr[0]), __uint_as_float(rr[1])); }
            const float mn = __builtin_fmaxf(mrow, rm), alpha = __builtin_amdgcn_exp2f(mrow - mn);
            float sacc = 0.f;
#pragma unroll
            for (int r = 0; r < 16; ++r) { p[r] = __builtin_amdgcn_exp2f(p[r] - mn); sacc += p[r]; }
            l_reg = l_reg * alpha + sacc;
            if (__any(mn > mrow)) {
                if (hi == 0) wsf[r32] = alpha;
                asm volatile("s_waitcnt lgkmcnt(0)" ::: "memory");
                const LAS f32x4v* A4 = (const LAS f32x4v*)wsf;
#pragma unroll
                for (int g = 0; g < 4; ++g) { const f32x4v av = A4[2 * g + hi];
#pragma unroll
                    for (int e = 0; e < 4; ++e) { o[0][4 * g + e] *= av[e]; o[1][4 * g + e] *= av[e]; } }
                asm volatile("s_waitcnt lgkmcnt(0)" ::: "memory");
            }
            mrow = mn;
            const u32x4 pw0 = (u32x4){cvtpk(p[0], p[1]), cvtpk(p[2], p[3]), cvtpk(p[4], p[5]), cvtpk(p[6], p[7])};
            const u32x4 pw1 = (u32x4){cvtpk(p[8], p[9]), cvtpk(p[10], p[11]), cvtpk(p[12], p[13]), cvtpk(p[14], p[15])};
            const bf16x8 pa0 = __builtin_bit_cast(bf16x8, pw0), pa1 = __builtin_bit_cast(bf16x8, pw1);
            { const int vb = (int)(lw + W_V + slot * 4096) + vbo;
              s16x4 lo[4], hh[4];
#pragma unroll
              for (int d0 = 0; d0 < 2; ++d0)
#pragma unroll
                  for (int ks = 0; ks < 2; ++ks) {
                      asm volatile("ds_read_b64_tr_b16 %0,%1 offset:%c2" : "=&v"(lo[d0 * 2 + ks]) : "v"(vb), "i"(d0 * 2048 + ks * 1024) : "memory");
                      asm volatile("ds_read_b64_tr_b16 %0,%1 offset:%c2" : "=&v"(hh[d0 * 2 + ks]) : "v"(vb), "i"(d0 * 2048 + ks * 1024 + 512) : "memory"); }
              asm volatile("s_waitcnt lgkmcnt(0)" ::: "memory"); __builtin_amdgcn_sched_barrier(0);
#define FW_PK(k) (bf16x8){lo[k][0], lo[k][1], lo[k][2], lo[k][3], hh[k][0], hh[k][1], hh[k][2], hh[k][3]}
              o[0] = __builtin_amdgcn_mfma_f32_32x32x16_bf16(pa0, FW_PK(0), o[0], 0, 0, 0);
              o[1] = __builtin_amdgcn_mfma_f32_32x32x16_bf16(pa0, FW_PK(2), o[1], 0, 0, 0);
              o[0] = __builtin_amdgcn_mfma_f32_32x32x16_bf16(pa1, FW_PK(1), o[0], 0, 0, 0);
              o[1] = __builtin_amdgcn_mfma_f32_32x32x16_bf16(pa1, FW_PK(3), o[1], 0, 0, 0);
#undef FW_PK
            }
            slot ^= 1;
        }
        { auto rr = __builtin_amdgcn_permlane32_swap(__float_as_uint(l_reg), __float_as_uint(l_reg), false, false); l_reg = __uint_as_float(rr[0]) + __uint_as_float(rr[1]); }
        if (hi == 0) wsf[32 + r32] = l_reg;
        asm volatile("s_waitcnt lgkmcnt(0)" ::: "memory");
        { const LAS f32x4v* L4 = (const LAS f32x4v*)(wsf + 32);
          LAS bf16* stg = (LAS bf16*)(wl + W_K + (slot ^ 1) * 4096);
#pragma unroll
          for (int g = 0; g < 4; ++g) { const f32x4v lv = L4[2 * g + hi];
#pragma unroll
              for (int e = 0; e < 4; ++e) { const float rl = __builtin_amdgcn_rcpf(lv[e]); const int orow = e + 8 * g + 4 * hi;
                  stg[orow * 64 + r32] = (bf16)f2bf(o[0][4 * g + e] * rl); stg[orow * 64 + 32 + r32] = (bf16)f2bf(o[1][4 * g + e] * rl); } }
          asm volatile("s_waitcnt lgkmcnt(0)" ::: "memory");
          bf16* Ow = O + (rbc + 32 * u) * DM + (bh % FH) * 64;
#pragma unroll
          for (int k = 0; k < 4; ++k) { const int row = k * 8 + (lane >> 3), ch = lane & 7; const u32x4 v = *(const LAS u32x4*)(stg + row * 64 + ch * 8); *(u32x4*)(Ow + (long)row * DM + ch * 8) = v; }
          asm volatile("s_waitcnt lgkmcnt(0)" ::: "memory"); }
        u = un; bh = bhn; jf = jfn; fref = frefn;
#pragma unroll
        for (int d0 = 0; d0 < 4; ++d0) qr[d0] = qn[d0];
    }
#undef FW_DMA
#undef FW_PTRS
#undef FW_BH
#undef FW_U
    asm volatile("s_waitcnt vmcnt(0) lgkmcnt(0)" ::: "memory"); __syncthreads();
}
}

namespace ml {
typedef short bf16x8 __attribute__((ext_vector_type(8)));
typedef short s16x4 __attribute__((ext_vector_type(4)));
typedef float f32x16 __attribute__((ext_vector_type(16)));
typedef float f32x4v __attribute__((ext_vector_type(4)));
typedef unsigned u32x4 __attribute__((ext_vector_type(4)));
typedef unsigned u32x2v __attribute__((ext_vector_type(2)));
constexpr int NCH = 64, L = 64, PLD = 3072;
constexpr int L_Q = 0, L_K = 32768, L_V = 65536, L_CB = 73728, CB_STRIDE = 272, CB_BYTES = 64 * CB_STRIDE, L_SCR = L_CB + 2 * CB_BYTES, SCR_BYTES = 2816;
static_assert(L_SCR + 8 * SCR_BYTES <= 131072, "mLSTM LDS map");
constexpr float SC_LOG2 = -3.5f;
__device__ __forceinline__ s16x4 trd(int addr, int off) { s16x4 v; asm volatile("ds_read_b64_tr_b16 %0,%1 offset:%c2" : "=&v"(v) : "v"(addr), "i"(off) : "memory"); return v; }
#define ML_TR(dst, addr, off) asm volatile("ds_read_b64_tr_b16 %0,%1 offset:%c2" : "=&v"(dst) : "v"(addr), "i"(off) : "memory")

__device__ __forceinline__ void mlstm_phase(Frame& F) {
    LAS unsigned char* shm = F.lds;
    const int tid = F.tid, lane = F.lane, r32 = lane & 31, hi = lane >> 5, bit = (lane >> 4) & 1, q4 = (lane & 15) >> 2, p4 = lane & 3;
    const int wid = F.wave;
    const int bx = blockIdx.x, vcu = (bx % 8) * (F.G / 8) + bx / 8, bh = vcu >> 3, slice = vcu & 7, b = bh / MH, h = bh % MH;
    const bf16* PROJ = (const bf16*)(F.ws + WS_RP);
    const bf16* qg = PROJ + (size_t)b * SEQ * PLD + h * MQK;
    const bf16* kg = PROJ + (size_t)b * SEQ * PLD + 512 + h * MQK;
    const bf16* vg = PROJ + (size_t)b * SEQ * PLD + 1024 + h * MV + slice * 32;
    bf16* NUM = (bf16*)(F.ws + WS_RB) + (size_t)b * SEQ * D + h * MV + slice * 32;
    float* DD = (float*)(F.ws + WS_F2) + (size_t)bh * SEQ;
    const float* IGp = (const float*)(F.ws + WS_IG) + (size_t)bh * SEQ; const float* LFp = (const float*)(F.ws + WS_LF) + (size_t)bh * SEQ;
    const unsigned lds0 = (unsigned)(size_t)shm;
    LAS float* scr = (LAS float*)(shm + L_SCR + wid * SCR_BYTES);
    const bf16* qsrc = qg + (size_t)lane * PLD + (2 * wid) * 8;
    const bf16* ksrc = kg + (size_t)lane * PLD + (2 * wid) * 8;
    const bf16* vsrc = vg + (size_t)(16 * (wid & 3) + (lane >> 2)) * PLD + (lane & 3) * 8;
#define ML_DMA(c, slot) do { const size_t ro_ = (size_t)(c) * L * PLD; \
        fa::glds16(qsrc + ro_, (unsigned)__builtin_amdgcn_readfirstlane(lds0 + L_Q + (slot) * 16384 + (2 * wid) * 1024)); \
        fa::glds16(qsrc + ro_ + 8, (unsigned)__builtin_amdgcn_readfirstlane(lds0 + L_Q + (slot) * 16384 + (2 * wid + 1) * 1024)); \
        fa::glds16(ksrc + ro_, (unsigned)__builtin_amdgcn_readfirstlane(lds0 + L_K + (slot) * 16384 + (2 * wid) * 1024)); \
        fa::glds16(ksrc + ro_ + 8, (unsigned)__builtin_amdgcn_readfirstlane(lds0 + L_K + (slot) * 16384 + (2 * wid + 1) * 1024)); \
        if (wid < 4) fa::glds16(vsrc + ro_, (unsigned)__builtin_amdgcn_readfirstlane(lds0 + L_V + (slot) * 4096 + wid * 1024)); } while (0)
    for (int i = tid; i < CB_BYTES / 4; i += NWAVES * 64) ((LAS unsigned*)(shm + L_CB))[i] = 0u;
    ML_DMA(0, 0);
    float ig_n = IGp[lane], lf_n = LFp[lane];
    float mrun = 0.f;
    f32x16 C0 = {}, C1 = {};
    const unsigned ones_w = (r32 == 0) ? 0x3F803F80u : 0u;
    const bf16x8 ONES = __builtin_bit_cast(bf16x8, (u32x4){ones_w, ones_w, ones_w, ones_w});
    asm volatile("s_waitcnt vmcnt(0) lgkmcnt(0)" ::: "memory"); __builtin_amdgcn_s_barrier();
    for (int c = 0; c < NCH; ++c) {
        const int slot = c & 1;
        const float ig = ig_n, lf = lf_n;
        float bsum = lf;
#pragma unroll
        for (int o = 1; o < 64; o <<= 1) { const float t = __shfl_up(bsum, o); if (lane >= o) bsum += t; }
        const float g = ig - bsum;
        float pm = g;
#pragma unroll
        for (int o = 1; o < 64; o <<= 1) { const float t = __shfl_up(pm, o); if (lane >= o) pm = __builtin_fmaxf(pm, t); }
        const float Mt = __builtin_fmaxf(mrun, pm);
        const float M63 = __shfl(Mt, 63), b63 = __shfl(bsum, 63);
        if (c + 1 < NCH) { ML_DMA(c + 1, slot ^ 1); ig_n = IGp[(c + 1) * L + lane]; lf_n = LFp[(c + 1) * L + lane]; }
        const int vb = (int)(lds0 + L_V + slot * 4096) + bit * 32 + p4 * 8 + (4 * hi + q4) * 64;
        if (wid < 4) {
            const int ti = wid >> 1, ci = wid & 1;
            scr[lane] = g; scr[64 + lane] = __builtin_amdgcn_exp2f((mrun - Mt) * LOG2E + SC_LOG2);
            const float Mt_l = __shfl(Mt, r32 + 32 * ti);
            const LAS unsigned char* Qs = shm + L_Q + slot * 16384; const LAS unsigned char* Ks = shm + L_K + slot * 16384;
            const LAS unsigned char* Cb = shm + L_CB + slot * CB_BYTES;
            bf16x8 qf[8];
#pragma unroll
            for (int ks = 0; ks < 8; ++ks) qf[ks] = *(const LAS bf16x8*)(Qs + (2 * ks + hi) * 1024 + (r32 + 32 * ti) * 16);
            f32x16 acc = {};
#pragma unroll
            for (int ks = 0; ks < 8; ++ks) { const bf16x8 cb = *(const LAS bf16x8*)(Cb + (r32 + 32 * ci) * CB_STRIDE + 32 * ks + 16 * hi); acc = __builtin_amdgcn_mfma_f32_32x32x16_bf16(qf[ks], cb, acc, 0, 0, 0); }
            asm volatile("s_waitcnt lgkmcnt(0)" ::: "memory");
            { const LAS f32x4v* A4 = (const LAS f32x4v*)(scr + 64);
#pragma unroll
              for (int gg = 0; gg < 4; ++gg) { const f32x4v av = A4[8 * ti + 2 * gg + hi];
#pragma unroll
                  for (int e = 0; e < 4; ++e) acc[4 * gg + e] *= av[e]; } }
            bf16x8 pa[4];
#pragma unroll
            for (int si = 0; si < 2; ++si) {
                if (si <= ti) {
                    f32x16 st = {};
#pragma unroll
                    for (int ks = 0; ks < 8; ++ks) { const bf16x8 kf = *(const LAS bf16x8*)(Ks + (2 * ks + hi) * 1024 + (r32 + 32 * si) * 16); st = __builtin_amdgcn_mfma_f32_32x32x16_bf16(kf, qf[ks], st, 0, 0, 0); }
                    const LAS f32x4v* G4 = (const LAS f32x4v*)(scr);
                    float pv_[16];
#pragma unroll
                    for (int gg = 0; gg < 4; ++gg) { const f32x4v gv = G4[8 * si + 2 * gg + hi];
#pragma unroll
                        for (int e = 0; e < 4; ++e) { const int r = 4 * gg + e; const float w = __builtin_amdgcn_exp2f((gv[e] - Mt_l) * LOG2E + SC_LOG2);
                            float val = st[r] * w; if (si == ti && (e + 8 * gg + 4 * hi) > r32) val = 0.f; pv_[r] = val; } }
                    u32x4 w0 = (u32x4){fa::cvtpk(pv_[0], pv_[1]), fa::cvtpk(pv_[2], pv_[3]), fa::cvtpk(pv_[4], pv_[5]), fa::cvtpk(pv_[6], pv_[7])};
                    u32x4 w1 = (u32x4){fa::cvtpk(pv_[8], pv_[9]), fa::cvtpk(pv_[10], pv_[11]), fa::cvtpk(pv_[12], pv_[13]), fa::cvtpk(pv_[14], pv_[15])};
                    pa[2 * si] = __builtin_bit_cast(bf16x8, w0); pa[2 * si + 1] = __builtin_bit_cast(bf16x8, w1);
                }
            }
            if (ci == 0) {
#pragma unroll
                for (int ks = 0; ks < 4; ++ks) {
                    if (ks < 2 * ti + 2) { s16x4 lo, hh; ML_TR(lo, vb, ks * 1024); ML_TR(hh, vb, ks * 1024 + 512);
                        asm volatile("s_waitcnt lgkmcnt(0)" ::: "memory"); __builtin_amdgcn_sched_barrier(0);
                        const bf16x8 vf = (bf16x8){lo[0], lo[1], lo[2], lo[3], hh[0], hh[1], hh[2], hh[3]};
                        acc = __builtin_amdgcn_mfma_f32_32x32x16_bf16(pa[ks], vf, acc, 0, 0, 0); }
                }
            } else {
#pragma unroll
                for (int ks = 0; ks < 4; ++ks) if (ks < 2 * ti + 2) acc = __builtin_amdgcn_mfma_f32_32x32x16_bf16(pa[ks], ONES, acc, 0, 0, 0);
            }
            asm volatile("s_waitcnt vmcnt(0)" ::: "memory");
            if (ci == 0) {
                LAS bf16* stg = (LAS bf16*)((LAS unsigned char*)scr + 768);
#pragma unroll
                for (int r = 0; r < 16; ++r) stg[fa::crow(r, hi) * 32 + r32] = (bf16)f2bf(acc[r]);
                asm volatile("s_waitcnt lgkmcnt(0)" ::: "memory");
#pragma unroll
                for (int i = 0; i < 2; ++i) { const int row = i * 16 + (lane >> 2), pc = lane & 3; const u32x4 v = *(const LAS u32x4*)(stg + row * 32 + pc * 8);
                    *(u32x4*)(NUM + (size_t)(c * L + 32 * ti + row) * D + pc * 8) = v; }
            } else {
                scr[192 + lane] = __builtin_amdgcn_exp2f(-(bsum + Mt) * LOG2E);
                asm volatile("s_waitcnt lgkmcnt(0)" ::: "memory");
                if (slice == 0 && r32 == 0) {
                    const LAS f32x4v* E4 = (const LAS f32x4v*)(scr + 192);
#pragma unroll
                    for (int gg = 0; gg < 4; ++gg) { const f32x4v ev = E4[8 * ti + 2 * gg + hi];
#pragma unroll
                        for (int e = 0; e < 4; ++e) DD[c * L + 32 * ti + e + 8 * gg + 4 * hi] = __builtin_fmaxf(__builtin_fabsf(acc[4 * gg + e]), ev[e]); }
                }
            }
        } else {
            const int dkt = wid - 4;
            scr[128 + lane] = __builtin_amdgcn_exp2f((g - M63) * LOG2E);
            const float a_c = __builtin_amdgcn_exp2f((mrun - M63) * LOG2E);
#pragma unroll
            for (int r = 0; r < 16; ++r) { C0[r] *= a_c; C1[r] *= a_c; }
            const int kb = (int)(lds0 + L_K + slot * 16384) + (4 * dkt + 2 * bit + (p4 >> 1)) * 1024 + (4 * hi + q4) * 16 + (p4 & 1) * 8;
            asm volatile("s_waitcnt lgkmcnt(0)" ::: "memory");
            const LAS f32x4v* W4 = (const LAS f32x4v*)(scr + 128);
#pragma unroll
            for (int ks = 0; ks < 4; ++ks) {
                s16x4 klo, khi, vlo, vhi; ML_TR(klo, kb, ks * 256); ML_TR(khi, kb, ks * 256 + 128); ML_TR(vlo, vb, ks * 1024); ML_TR(vhi, vb, ks * 1024 + 512);
                const f32x4v wl = W4[4 * ks + hi], wh = W4[4 * ks + 2 + hi];
                asm volatile("s_waitcnt lgkmcnt(0)" ::: "memory"); __builtin_amdgcn_sched_barrier(0);
                u32x4 aw;
                aw.x = fa::cvtpk(bf2f((unsigned short)klo[0]) * wl[0], bf2f((unsigned short)klo[1]) * wl[1]); aw.y = fa::cvtpk(bf2f((unsigned short)klo[2]) * wl[2], bf2f((unsigned short)klo[3]) * wl[3]);
                aw.z = fa::cvtpk(bf2f((unsigned short)khi[0]) * wh[0], bf2f((unsigned short)khi[1]) * wh[1]); aw.w = fa::cvtpk(bf2f((unsigned short)khi[2]) * wh[2], bf2f((unsigned short)khi[3]) * wh[3]);
                const bf16x8 af = __builtin_bit_cast(bf16x8, aw);
                const bf16x8 vf = (bf16x8){vlo[0], vlo[1], vlo[2], vlo[3], vhi[0], vhi[1], vhi[2], vhi[3]};
                C0 = __builtin_amdgcn_mfma_f32_32x32x16_bf16(af, vf, C0, 0, 0, 0);
                C1 = __builtin_amdgcn_mfma_f32_32x32x16_bf16(af, ONES, C1, 0, 0, 0);
            }
            LAS unsigned char* Cn = shm + L_CB + (slot ^ 1) * CB_BYTES;
#pragma unroll
            for (int gg = 0; gg < 4; ++gg) {
                u32x2v w0; w0.x = fa::cvtpk(C0[4 * gg], C0[4 * gg + 1]); w0.y = fa::cvtpk(C0[4 * gg + 2], C0[4 * gg + 3]);
                u32x2v w1; w1.x = fa::cvtpk(C1[4 * gg], C1[4 * gg + 1]); w1.y = fa::cvtpk(C1[4 * gg + 2], C1[4 * gg + 3]);
                *(LAS u32x2v*)(Cn + r32 * CB_STRIDE + (32 * dkt + 8 * gg + 4 * hi) * 2) = w0;
                *(LAS u32x2v*)(Cn + (r32 + 32) * CB_STRIDE + (32 * dkt + 8 * gg + 4 * hi) * 2) = w1;
            }
            asm volatile("s_waitcnt vmcnt(0)" ::: "memory");
        }
        mrun = b63 + M63;
        asm volatile("s_waitcnt lgkmcnt(0)" ::: "memory"); __builtin_amdgcn_s_barrier(); asm volatile("" ::: "memory");
    }
#undef ML_DMA
    asm volatile("s_waitcnt vmcnt(0) lgkmcnt(0)" ::: "memory"); __syncthreads();
}
#undef ML_TR
}

constexpr int NPHASES = 17;
struct Args { const float* in[21]; float* out; unsigned char* ws; int ph_lo, ph_hi, use_bar, pad; };
__global__ void __launch_bounds__(NWAVES * 64, 2) yoco_fwd(Args args) {
    extern __shared__ __attribute__((aligned(16))) unsigned char lds[];
    Frame F;
    F.lds = (LAS unsigned char*)lds;
    F.MISC = (volatile LAS unsigned*)(F.lds + MISC_OFF);
    F.tid = threadIdx.x; F.lane = F.tid & 63; F.wave = __builtin_amdgcn_readfirstlane(F.tid >> 6);
    F.G = gridDim.x;
    F.ws = args.ws; F.out = args.out; F.ctl = (gu32*)(args.ws + WS_CTL);
    F.in = args.in;
    for (int u = F.tid; u < (LDS_BYTES - LDSCTL_OFF) / 4; u += NWAVES * 64) ((LAS unsigned*)(F.lds + LDSCTL_OFF))[u] = 0u;
    __syncthreads();
    XcdBarrier bar; bar.bar = (unsigned*)(F.ctl + CW_BAR); bar.x = 0; bar.st = nullptr;
    if (args.use_bar) bar = xcd_barrier_post((unsigned*)(F.ctl + CW_BAR), F.MISC + 8);

    const int lo = args.ph_lo, hi = args.ph_hi;
#ifndef ATTN_SKIP
#define ATTN_SKIP true
#endif
#ifndef PROBE_MASK
#define PROBE_MASK 0
#endif
#define IN(k) (lo <= (k) && (k) < hi)
#define RUN(k, ...) do { if (IN(k)) { __VA_ARGS__; if (((PROBE_MASK) >> (k)) & 1) { __VA_ARGS__; } } } while (0)
#define SEAM(k) do { if (IN(k) && (k) > lo) xcd_barrier(bar); } while (0)
#define WSP(off) (args.ws + (off))
#define MODP ((const float*)(args.ws + WS_MOD))
#define NRMP ((unsigned*)(args.ws + WS_CTL) + CW_NORM)
#define GEMM_BF16(Aoff, Boff, N_, K_, Ooff, ldc_, split_, stride_, scale_, nrm_, which_) do { \
        pg8::Gemm g{(const pg8::bf16_t*)WSP(Aoff), (const pg8::bf16_t*)WSP(Boff), M, (N_), (K_)}; pg8::StaticOrder S; S.init(M, (N_), F.G, (int)blockIdx.x); \
        pg8::EpiBf16 E{(pg8::bf16_t*)WSP(Ooff), (ldc_), (split_), (size_t)(stride_), (scale_), (nrm_), (which_)}; \
        pg8::gemm_phase<pg8::EpiBf16, pg8::StaticOrder, true, true>(F.lds + RING_OFF, g, S, E); } while (0)
#define GEMM_SWIGLU(Aoff, Boff, Ooff) do { \
        pg8::Gemm g{(const pg8::bf16_t*)WSP(Aoff), (const pg8::bf16_t*)WSP(Boff), M, 2 * DFF, D}; pg8::StaticOrder S; S.init(M, 2 * DFF, F.G, (int)blockIdx.x); \
        pg8::EpiSwiGLU E{(pg8::bf16_t*)WSP(Ooff), DFF}; \
        pg8::gemm_phase<pg8::EpiSwiGLU, pg8::StaticOrder, true, true>(F.lds + RING_OFF, g, S, E); } while (0)

    SEAM(0); RUN(0, p0_prologue(F));
    SEAM(1); RUN(1, row_phase_A(F));
    SEAM(2); RUN(2, GEMM_BF16(WS_RA, WS_WA_IN, M_INP, D, WS_RP, M_INP, 0, 0, 1.f, nullptr, 0));
    SEAM(3); RUN(3, ml::mlstm_phase(F));
    SEAM(4); RUN(4, row_phase_B(F));
    SEAM(5); RUN(5, GEMM_BF16(WS_RA, WS_WA_OUT, D, D, WS_RD, D, 0, 0, 1.f, nullptr, 0));
    SEAM(6); RUN(6, row_phase_C<0, 0>(F, args.in[I_X], args.in[I_MIX_POST_G], MODP + 2048, args.in[I_FFN_PRE_G], MODP + 3072));
    SEAM(7); RUN(7, GEMM_SWIGLU(WS_RA, WS_WFI, WS_RP));
    SEAM(8); RUN(8, GEMM_BF16(WS_RP, WS_WFO, D, DFF, WS_RD, D, 0, 0, 1.f, nullptr, 0));
    SEAM(9); RUN(9, row_phase_C<1, 1>(F, nullptr, args.in[I_FFN_POST_G], MODP + 5120, args.in[I_MIX_PRE_G] + 1024, MODP + (size_t)8 * 6144));
    SEAM(10); RUN(10, { cumsum_f2(F);
                        GEMM_BF16(WS_RB, WS_WKV, 2048, D, WS_RP + 64 * MiB, D, 1024, (size_t)M * D, 1.f, NRMP, 1);
                        GEMM_BF16(WS_RA, WS_WQ, D, D, WS_RP, D, 1024, 0, QSCALE2, NRMP, 0); });
    SEAM(11); RUN(11, fw::attn_phase<ATTN_SKIP>(F));
    SEAM(12); RUN(12, GEMM_BF16(WS_RB, WS_WBO, D, D, WS_RD, D, 0, 0, 1.f, nullptr, 0));
    SEAM(13); RUN(13, row_phase_C<0, 1>(F, nullptr, args.in[I_MIX_POST_G] + 1024, MODP + (size_t)8 * 6144 + 2048, args.in[I_FFN_PRE_G] + 1024, MODP + (size_t)8 * 6144 + 3072));
    SEAM(14); RUN(14, GEMM_SWIGLU(WS_RA, WS_WFI + WFI_STRIDE, WS_RP));
    SEAM(15); RUN(15, GEMM_BF16(WS_RP, WS_WFO + WFO_STRIDE, D, DFF, WS_RD, D, 0, 0, 1.f, nullptr, 0));
    SEAM(16); RUN(16, row_phase_C<2, 1>(F, nullptr, args.in[I_FFN_POST_G] + 1024, MODP + (size_t)8 * 6144 + 5120, nullptr, nullptr));
}

#ifndef MK_PER_PHASE
#define MK_PER_PHASE 0
#endif
extern "C" void kernel_launch(void* const* d_in, const int* in_sizes, int n_in, void* d_out, int out_size, void* d_ws, size_t ws_size, hipStream_t stream) {
    static int grid = 0;
    if (grid == 0) {
        if (n_in != 21 || in_sizes[0] != M * D || out_size != M * D || ws_size < WS_END) { fprintf(stderr, "kernel_launch: unexpected shapes: n_in %d in0 %d out %d ws %zu (need %zu)\n", n_in, n_in > 0 ? in_sizes[0] : -1, out_size, ws_size, (size_t)WS_END); grid = -1; return; }
        int dev = 0, cus = 0, per_cu = 0;
        if (hipGetDevice(&dev) != hipSuccess || hipDeviceGetAttribute(&cus, hipDeviceAttributeMultiprocessorCount, dev) != hipSuccess) { grid = -1; return; }
        if (hipFuncSetAttribute((const void*)yoco_fwd, hipFuncAttributeMaxDynamicSharedMemorySize, LDS_BYTES) != hipSuccess) { fprintf(stderr, "kernel_launch: hipFuncSetAttribute failed\n"); grid = -1; return; }
        if (hipOccupancyMaxActiveBlocksPerMultiprocessor(&per_cu, (const void*)yoco_fwd, NWAVES * 64, LDS_BYTES) != hipSuccess || per_cu < 1)
            fprintf(stderr, "kernel_launch: note: occupancy query reports %d workgroups per CU\n", per_cu);
        (void)hipGetLastError();
        grid = cus;
        if (grid != 256) { fprintf(stderr, "kernel_launch: built for 256 CUs, device has %d\n", grid); }
    }
    if (grid < 0) return;
    if (hipMemsetAsync((char*)d_ws + WS_CTL, 0, CTL_ZERO_BYTES, stream) != hipSuccess) { fprintf(stderr, "kernel_launch: hipMemsetAsync failed\n"); return; }
    Args a{};
    for (int i = 0; i < 21; ++i) a.in[i] = (const float*)d_in[i];
    a.out = (float*)d_out; a.ws = (unsigned char*)d_ws;
#if MK_PER_PHASE
    for (int ph = 0; ph < NPHASES; ++ph) {
        a.ph_lo = ph; a.ph_hi = ph + 1; a.use_bar = 0;
        hipLaunchKernelGGL(yoco_fwd, dim3(256), dim3(NWAVES * 64), LDS_BYTES, stream, a);
    }
#else
    a.ph_lo = 0; a.ph_hi = NPHASES; a.use_bar = 1;
    hipLaunchKernelGGL(yoco_fwd, dim3(256), dim3(NWAVES * 64), LDS_BYTES, stream, a);
#endif
    const hipError_t le = hipPeekAtLastError();
    if (le != hipSuccess) fprintf(stderr, "kernel_launch: launch failed: %s\n", hipGetErrorName(le));
}
```
